# Optimizing an MI355X kernel written in HIP

```python
import jax, jax.numpy as jnp
from jax import lax
import numpy as np

D_MODEL = 2048
BATCH = 4
SEQ = 2048
DEPTH = 1

RET_HEADS = 8
RET_HEAD_DIM = D_MODEL // 16
RET_WIDTH = RET_HEADS * RET_HEAD_DIM
RET_CHUNK = 128
DSA_HEADS = 8
DSA_HEAD_DIM = D_MODEL // 16
DSA_WIDTH = DSA_HEADS * DSA_HEAD_DIM
IDX_HEADS = 16
IDX_DIM = 64
IDX_TOPK_MAX = 256
Q_BLOCK = 128
MEM_TOKENS = 256
MEM_HEADS = 4
MEM_HEAD_DIM = D_MODEL // 8
MEM_WIDTH = MEM_HEADS * MEM_HEAD_DIM
N_BRANCHES = 3
NEG_INF = -1e30
EPS = 1e-6

W_IN_SPLITS = (RET_WIDTH, RET_WIDTH, RET_WIDTH, RET_WIDTH,
               DSA_WIDTH, DSA_WIDTH, DSA_WIDTH, DSA_WIDTH,
               IDX_HEADS * IDX_DIM, IDX_DIM, IDX_HEADS,
               MEM_WIDTH, MEM_WIDTH,
               D_MODEL, D_MODEL, D_MODEL)
W_IN_COLS = sum(W_IN_SPLITS)

kernel_name = "hybrid_retention_dsa_memory_gated_block"


def rms_norm(x, w):
    xf = x.astype(jnp.float32)
    y = xf * lax.rsqrt(jnp.mean(xf * xf, axis=-1, keepdims=True) + EPS)
    return (y * w.astype(jnp.float32)).astype(x.dtype)


def alibi_slopes(n):
    return 2.0 ** (-8.0 * (jnp.arange(n, dtype=jnp.float32) + 1.0) / n)


def retention(q, k, v):
    B, H, L, dk = q.shape
    dv = v.shape[-1]
    C = RET_CHUNK
    N = L // C
    q, k, v = (t.astype(jnp.float32) for t in (q, k, v))
    log_g = jnp.log1p(-(2.0 ** (-5.0 - jnp.arange(H, dtype=jnp.float32))))
    idx = jnp.arange(C, dtype=jnp.float32)
    diff = idx[:, None] - idx[None, :]
    decay = jnp.where(diff >= 0, jnp.exp(log_g[:, None, None] * jnp.maximum(diff, 0.0)), 0.0)
    q_dec = jnp.exp(log_g[:, None] * (idx + 1.0))[None, :, :, None]
    k_dec = jnp.exp(log_g[:, None] * (C - 1.0 - idx))[None, :, :, None]
    chunk_dec = jnp.exp(log_g * C)[None, :, None, None]

    def to_chunks(t):
        return t.reshape(B, H, N, C, t.shape[-1]).transpose(2, 0, 1, 3, 4)

    def step(state, inp):
        qi, ki, vi = inp
        inner = jnp.einsum('bhid,bhjd->bhij', qi, ki) * decay[None]
        o = (jnp.einsum('bhij,bhjv->bhiv', inner, vi)
             + jnp.einsum('bhid,bhdv->bhiv', qi * q_dec, state))
        state = state * chunk_dec + jnp.einsum('bhjd,bhjv->bhdv', ki * k_dec, vi)
        return state, o

    s0 = jnp.zeros((B, H, dk, dv), jnp.float32)
    _, o = lax.scan(step, s0, (to_chunks(q), to_chunks(k), to_chunks(v)))
    return o.transpose(1, 2, 0, 3, 4).reshape(B, H, L, dv)


def head_group_norm(o, w):
    mu = jnp.mean(o, axis=-1, keepdims=True)
    var = jnp.mean(jnp.square(o - mu), axis=-1, keepdims=True)
    on = (o - mu) * lax.rsqrt(var + 1e-5)
    B, H, L, dv = o.shape
    return on.transpose(0, 2, 1, 3).reshape(B, L, H * dv) * w.astype(jnp.float32)


def dsa_attention(q, k, v, q_idx, k_idx, w_idx, top_k):
    B, L, H, D = q.shape
    nb = L // Q_BLOCK
    slopes = alibi_slopes(H)
    key_pos = jnp.arange(L)
    k_idx_f = k_idx.astype(jnp.float32)

    def blocks(t):
        return t.reshape((B, nb, Q_BLOCK) + t.shape[2:]).swapaxes(0, 1)

    def one_block(args):
        qb, qib, wb, qpos = args
        s = jnp.einsum('bqhe,bse->bqhs', qib.astype(jnp.float32), k_idx_f) * (IDX_DIM ** -0.5)
        score = jnp.einsum('bqh,bqhs->bqs', wb.astype(jnp.float32), jax.nn.relu(s))
        causal = key_pos[None, :] <= qpos[:, None]
        score = jnp.where(causal[None], score, NEG_INF)
        _, sel = lax.top_k(score, top_k)
        valid = sel <= qpos[None, :, None]
        k_sel = jax.vmap(lambda kb, ib: kb[ib])(k, sel)
        v_sel = jax.vmap(lambda vb, ib: vb[ib])(v, sel)
        logits = jnp.einsum('bqhd,bqkhd->bqhk', qb, k_sel).astype(jnp.float32) * (D ** -0.5)
        dist = (qpos[None, :, None] - sel).astype(jnp.float32)
        logits = logits - slopes[None, None, :, None] * dist[:, :, None, :]
        logits = jnp.where(valid[:, :, None, :], logits, NEG_INF)
        p = jax.nn.softmax(logits, axis=-1).astype(v.dtype)
        return jnp.einsum('bqhk,bqkhd->bqhd', p, v_sel)

    qpos_blocks = jnp.arange(L).reshape(nb, Q_BLOCK)
    out = lax.map(one_block, (blocks(q), blocks(q_idx), blocks(w_idx), qpos_blocks))
    return out.swapaxes(0, 1).reshape(B, L, H, D)


def memory_cross_attention(q, mem, mem_norm_w, w_mem_kv):
    B, L, _ = q.shape
    M = mem.shape[1]
    kv = rms_norm(mem, mem_norm_w) @ w_mem_kv
    km, vm = jnp.split(kv, 2, axis=-1)
    km = km.reshape(B, M, MEM_HEADS, MEM_HEAD_DIM)
    vm = vm.reshape(B, M, MEM_HEADS, MEM_HEAD_DIM)
    qh = q.reshape(B, L, MEM_HEADS, MEM_HEAD_DIM)
    logits = jnp.einsum('blhd,bmhd->bhlm', qh, km).astype(jnp.float32) * (MEM_HEAD_DIM ** -0.5)
    p = jax.nn.softmax(logits, axis=-1).astype(vm.dtype)
    return jnp.einsum('bhlm,bmhd->blhd', p, vm).reshape(B, L, MEM_WIDTH)


def hybrid_layer(x, mem, pre_norm_w, w_in, ret_gn_w, mem_norm_w, w_mem_kv,
                 w_up_ret, w_up_dsa, w_up_mem, w_o, post_norm_w):
    B, L, _ = x.shape
    top_k = min(IDX_TOPK_MAX, L // 4)
    h = rms_norm(x, pre_norm_w)
    z = h @ w_in
    points = np.cumsum(W_IN_SPLITS)[:-1].tolist()
    (rq, rk, rv, rg, aq, ak, av, ag, iq, ik, iw, mq, mg,
     g_ret, g_dsa, g_mem) = jnp.split(z, points, axis=-1)

    def heads_first(t, n):
        return t.reshape(B, L, n, -1).transpose(0, 2, 1, 3)
    o_ret = retention(heads_first(rq, RET_HEADS),
                      heads_first(rk, RET_HEADS) * (RET_HEAD_DIM ** -0.5),
                      heads_first(rv, RET_HEADS))
    y_ret = jax.nn.silu(rg) * head_group_norm(o_ret, ret_gn_w).astype(x.dtype)

    o_dsa = dsa_attention(aq.reshape(B, L, DSA_HEADS, DSA_HEAD_DIM),
                          ak.reshape(B, L, DSA_HEADS, DSA_HEAD_DIM),
                          av.reshape(B, L, DSA_HEADS, DSA_HEAD_DIM),
                          iq.reshape(B, L, IDX_HEADS, IDX_DIM), ik,
                          iw * (IDX_HEADS ** -0.5), top_k)
    y_dsa = jax.nn.silu(ag) * o_dsa.reshape(B, L, DSA_WIDTH)

    y_mem = jax.nn.silu(mg) * memory_cross_attention(mq, mem, mem_norm_w, w_mem_kv)

    merged = (jax.nn.sigmoid(g_ret) * (y_ret @ w_up_ret)
              + jax.nn.sigmoid(g_dsa) * (y_dsa @ w_up_dsa)
              + jax.nn.sigmoid(g_mem) * (y_mem @ w_up_mem))
    out = merged @ w_o
    return x + rms_norm(out, post_norm_w)


def setup_inputs(seed: int = 0) -> dict:
    key = jax.random.key(seed)
    ks = jax.random.split(key, 14)
    f32 = jnp.float32

    def nrm(k, shape, fan_in):
        return jax.random.normal(k, shape, f32) * (fan_in ** -0.5)

    def gain(k, shape):
        return 1.0 + 0.02 * jax.random.normal(k, shape, f32)

    return {
        "x": jax.random.normal(ks[0], (BATCH, SEQ, D_MODEL), f32),
        "mem": jax.random.normal(ks[1], (BATCH, MEM_TOKENS, D_MODEL), f32),
        "pre_norm_w": gain(ks[2], (DEPTH, D_MODEL)),
        "w_in": nrm(ks[3], (DEPTH, D_MODEL, W_IN_COLS), D_MODEL),
        "ret_gn_w": gain(ks[4], (DEPTH, RET_WIDTH)),
        "mem_norm_w": gain(ks[5], (DEPTH, D_MODEL)),
        "w_mem_kv": nrm(ks[6], (DEPTH, D_MODEL, 2 * MEM_WIDTH), D_MODEL),
        "w_up_ret": nrm(ks[7], (DEPTH, RET_WIDTH, D_MODEL), RET_WIDTH),
        "w_up_dsa": nrm(ks[8], (DEPTH, DSA_WIDTH, D_MODEL), DSA_WIDTH),
        "w_up_mem": nrm(ks[9], (DEPTH, MEM_WIDTH, D_MODEL), MEM_WIDTH),
        "w_o": nrm(ks[10], (DEPTH, D_MODEL, D_MODEL), D_MODEL),
        "post_norm_w": gain(ks[11], (DEPTH, D_MODEL)),
    }


def reference(x, mem, pre_norm_w, w_in, ret_gn_w, mem_norm_w, w_mem_kv,
              w_up_ret, w_up_dsa, w_up_mem, w_o, post_norm_w):
    for layer in range(DEPTH):
        x = hybrid_layer(x, mem, pre_norm_w[layer], w_in[layer], ret_gn_w[layer],
                         mem_norm_w[layer], w_mem_kv[layer], w_up_ret[layer],
                         w_up_dsa[layer], w_up_mem[layer], w_o[layer], post_norm_w[layer])
    return x
```

```cpp
#include <hip/hip_runtime.h>
#include <cstdio>
#include <cstdint>

#ifndef MK_N_LAUNCHES
#define MK_N_LAUNCHES 1
#endif

#define GAS __attribute__((address_space(1)))
#define LAS __attribute__((address_space(3)))
typedef unsigned short bf16;
typedef short bf16x8 __attribute__((ext_vector_type(8)));
typedef float f32x4 __attribute__((ext_vector_type(4)));
typedef unsigned u32x4 __attribute__((ext_vector_type(4)));
typedef unsigned u32x2 __attribute__((ext_vector_type(2)));
typedef GAS unsigned gu32;
#define RLX_AGENT __ATOMIC_RELAXED, __HIP_MEMORY_SCOPE_AGENT
#define DI __device__ __forceinline__

constexpr int NB = 4, SEQ = 2048, DM = 2048, MTOK = NB * SEQ;
constexpr int NIN = 17488, ZLD = 17664;
constexpr int MEMT = 256, MROWS = NB * MEMT;
constexpr int ZC_RQ = 0, ZC_RK = 1024, ZC_RV = 2048, ZC_RG = 3072, ZC_AQ = 4096, ZC_AK = 5120, ZC_AV = 6144, ZC_AG = 7168,
              ZC_IQ = 8192, ZC_IK = 9216, ZC_IW = 9280, ZC_PAD = 9296, ZC_MQ = 9472, ZC_MG = 10496, ZC_GR = 11520, ZC_GD = 13568, ZC_GM = 15616;
constexpr int TOPK = 256;

constexpr size_t MiB = 1u << 20;
constexpr size_t WS_CTL = 0, CTL_ZERO_BYTES = 1 * MiB;
constexpr size_t WS_WINT = 1 * MiB;
constexpr size_t WS_MRG = 1 * MiB;
constexpr size_t WS_WKVT = 70 * MiB;
constexpr size_t WS_WUPT = 78 * MiB;
constexpr size_t WS_WOT = 90 * MiB;
constexpr size_t WS_HB = 98 * MiB;
constexpr size_t WS_MERGED = 98 * MiB;
constexpr size_t WS_MEMN = 130 * MiB;
constexpr size_t WS_KVM = 134 * MiB;
constexpr size_t WS_MASK = 138 * MiB;
constexpr size_t WS_YB = 141 * MiB;
constexpr size_t WS_Z = 189 * MiB;
constexpr size_t WS_END = 465 * MiB;
static_assert(WS_WINT + (size_t)ZLD * DM * 2 <= WS_WKVT && WS_Z + (size_t)MTOK * ZLD * 2 <= WS_END, "ws map");

constexpr int CW_BAR = 4096;

constexpr int NWAVES = 8, NTHR = 512;
constexpr int LDS_BYTES = 147456;
constexpr int MISC_OFF = 139264;

DI unsigned f2bf(float f) { unsigned u = __builtin_bit_cast(unsigned, f); return (u + 0x7fffu + ((u >> 16) & 1u)) >> 16; }
DI unsigned pk2(float lo, float hi) { return f2bf(lo) | (f2bf(hi) << 16); }
DI float bf2f(unsigned h) { return __builtin_bit_cast(float, h << 16); }
DI float bflo(unsigned w) { return __builtin_bit_cast(float, w << 16); }
DI float bfhi(unsigned w) { return __builtin_bit_cast(float, w & 0xffff0000u); }
DI float wave_sum(float v) {
#pragma unroll
    for (int o = 1; o < 64; o <<= 1) v += __shfl_xor(v, o);
    return v;
}
DI int wave_sum_i(int v) {
#pragma unroll
    for (int o = 1; o < 64; o <<= 1) v += __shfl_xor(v, o);
    return v;
}
DI float wave_max(float v) {
#pragma unroll
    for (int o = 1; o < 64; o <<= 1) v = fmaxf(v, __shfl_xor(v, o));
    return v;
}
DI float silu_f(float x) { return x / (1.f + __expf(-x)); }
DI float sigmoid_f(float x) { return 1.f / (1.f + __expf(-x)); }

#define XB_TMO      128
#define XB_XCNT(j)  (256  + 64 * (j))
#define XB_XSUB(j)  (1280 + 64 * (j))
#define XB_XGEN(j)  (2304 + 64 * (j))
#define XB_TOP      3328
#define XB_TOPGEN   3392
#define XCD_BAR_WORDS 3456
#define XB_SPIN_CAP (1u << 22)
DI unsigned xb_ld(unsigned* p)              { return __hip_atomic_load(p, __ATOMIC_RELAXED, __HIP_MEMORY_SCOPE_AGENT); }
DI unsigned xb_add(unsigned* p, unsigned v) { return __hip_atomic_fetch_add(p, v, __ATOMIC_RELAXED, __HIP_MEMORY_SCOPE_AGENT); }
DI unsigned xb_xcc_id() { return (unsigned)__builtin_amdgcn_s_getreg((3 << 11) | 20) & 0xFu; }
#define XB_SPIN(cond, bar) do { unsigned _sp = 0; while (cond) { __builtin_amdgcn_s_sleep(1); \
    if ((++_sp & 255u) == 0u) { if (xb_ld(&(bar)[XB_TMO])) break; if (_sp > XB_SPIN_CAP) { atomicAdd(&(bar)[XB_TMO], 1u); break; } } } } while (0)
struct XcdBarrier { unsigned* bar; unsigned x; volatile LAS unsigned* st; };
DI XcdBarrier xcd_barrier_post(unsigned* bar, volatile LAS unsigned* st) {
    XcdBarrier b; b.bar = bar; b.x = xb_xcc_id(); b.st = st;
    if (threadIdx.x == 0) (void)xb_add(&bar[XB_XCNT(b.x)], 1u);
    return b;
}
DI void xcd_barrier_complete(unsigned* bar, unsigned x, unsigned& nloc, unsigned& nx) {
    const unsigned G = gridDim.x * gridDim.y * gridDim.z;
    unsigned sum, cnt, mine, sp = 0u;
    for (;;) {
        sum = 0u; cnt = 0u; mine = 0u;
#pragma unroll
        for (unsigned j = 0; j < 16; ++j) { const unsigned c = xb_ld(&bar[XB_XCNT(j)]); sum += c; cnt += (c > 0u) ? 1u : 0u; mine = (j == x) ? c : mine; }
        if (sum == G) break;
        __builtin_amdgcn_s_sleep(1);
        if ((++sp & 255u) == 0u) { if (xb_ld(&bar[XB_TMO])) break; if (sp > XB_SPIN_CAP) { atomicAdd(&bar[XB_TMO], 1u); break; } }
    }
    nloc = mine > 0u ? mine : 1u; nx = cnt > 0u ? cnt : 1u;
}
DI void xcd_barrier(const XcdBarrier& b) {
    asm volatile("s_waitcnt vmcnt(0)" ::: "memory");
    __syncthreads();
    if (threadIdx.x == 0) {
        unsigned* bar = b.bar;
        __builtin_amdgcn_s_waitcnt(0);
        unsigned nloc = b.st[0], nx = b.st[1];
        if (nloc == 0u) { xcd_barrier_complete(bar, b.x, nloc, nx); b.st[0] = nloc; b.st[1] = nx; }
        const unsigned old = xb_add(&bar[XB_XSUB(b.x)], 1u);
        const unsigned gen = old / nloc;
        if (old + 1u == (gen + 1u) * nloc) {
            __builtin_amdgcn_fence(__ATOMIC_RELEASE, "agent");
            asm volatile("s_waitcnt vmcnt(0)" ::: "memory");
            const unsigned og = xb_add(&bar[XB_TOP], 1u);
            const unsigned tg = og / nx;
            if (og + 1u == (tg + 1u) * nx) xb_add(&bar[XB_TOPGEN], 1u);
            else XB_SPIN(xb_ld(&bar[XB_TOPGEN]) == tg, bar);
            __builtin_amdgcn_fence(__ATOMIC_ACQUIRE, "agent");
            xb_add(&bar[XB_XGEN(b.x)], 1u);
            asm volatile("s_waitcnt vmcnt(0)" ::: "memory");
        } else {
            XB_SPIN(xb_ld(&bar[XB_XGEN(b.x)]) == gen, bar);
            __builtin_amdgcn_fence(__ATOMIC_ACQUIRE, "agent");
            asm volatile("s_waitcnt vmcnt(0)" ::: "memory");
        }
    }
    __syncthreads();
}

struct Frame {
    LAS unsigned char* lds;
    int tid, lane, wave, G;
    const float *x, *mem, *pre_w, *w_in, *gn_w, *memn_w, *w_kv, *w_up[3], *w_o, *post_w;
    float* out;
    bf16 *WinT, *WkvT, *WupT, *WoT, *Hb, *MemN, *KVm, *Yb, *Z, *Merged;
    float* Mrg;
    unsigned* Mask;
};

template <int KIND> DI int src_col(int n) { if (KIND == 0) return n < ZC_PAD ? n : (n < ZC_MQ ? -1 : n - (ZC_MQ - ZC_PAD)); return n; }
template <int KIND> DI float src_scale(int n) {
    if (KIND == 0) {
        if ((n >= ZC_RK && n < ZC_RV) || (n >= ZC_AQ && n < ZC_AK)) return 0.08838834764831845f;
        if (n >= ZC_IQ && n < ZC_IK) return 0.125f;
        if (n >= ZC_IW && n < ZC_PAD) return 0.25f;
        if (n >= ZC_MQ && n < ZC_MG) return 0.0625f;
    }
    return 1.f;
}
template <int KIND> DI void p0_transpose_item(const float* W, int K, int Nsrc, int Ndst, bf16* WT, LAS float* scr, int item, int lane) {
    const int nblk = Ndst / 64, kb = item / nblk, nb = item % nblk, k0 = 64 * kb, n0 = 64 * nb;
    const int sc = src_col<KIND>(n0 + lane); const float s = src_scale<KIND>(n0 + lane);
    const float* src = W + (size_t)k0 * Nsrc + (sc < 0 ? 0 : sc);
#pragma unroll 8
    for (int i = 0; i < 64; ++i) { const float v = src[(size_t)i * Nsrc]; scr[i * 65 + lane] = sc < 0 ? 0.f : v * s; }
    asm volatile("s_waitcnt lgkmcnt(0)" ::: "memory");
    const int c = lane & 7;
#pragma unroll
    for (int j = 0; j < 8; ++j) { const int n = (lane >> 3) + 8 * j; const LAS float* p = scr + (8 * c) * 65 + n;
        u32x4 o; o.x = pk2(p[0 * 65], p[1 * 65]); o.y = pk2(p[2 * 65], p[3 * 65]); o.z = pk2(p[4 * 65], p[5 * 65]); o.w = pk2(p[6 * 65], p[7 * 65]);
        *(u32x4*)(WT + (size_t)(n0 + n) * K + k0 + 8 * c) = o; }
    asm volatile("s_waitcnt lgkmcnt(0)" ::: "memory");
}
DI void rms_row_to_bf16(const float* xrow, const float* w, bf16* orow, float eps, int lane) {
    const f32x4* xr = (const f32x4*)xrow + lane; const f32x4* wr = (const f32x4*)w + lane;
    f32x4 v[8]; float s = 0.f;
#pragma unroll
    for (int j = 0; j < 8; ++j) { v[j] = xr[64 * j]; s += (v[j].x * v[j].x + v[j].y * v[j].y) + (v[j].z * v[j].z + v[j].w * v[j].w); }
    const float r = 1.0f / sqrtf(wave_sum(s) * (1.f / DM) + eps);
    u32x2* o8 = (u32x2*)orow + lane;
#pragma unroll
    for (int j = 0; j < 8; ++j) { const f32x4 ww = wr[64 * j]; u32x2 o; o.x = pk2(v[j].x * r * ww.x, v[j].y * r * ww.y); o.y = pk2(v[j].z * r * ww.z, v[j].w * r * ww.w); o8[64 * j] = o; }
}
DI void p0_prologue(Frame& F) {
    LAS float* scr = (LAS float*)(F.lds + F.wave * 16640);
    const int gw = blockIdx.x * NWAVES + F.wave, NGW = F.G * NWAVES;
    constexpr int I_IN = (DM / 64) * (ZLD / 64), I_KV = (DM / 64) * (2048 / 64), I_UP = (1024 / 64) * (DM / 64), I_O = (DM / 64) * (DM / 64);
    constexpr int NITEMS = I_IN + I_KV + 3 * I_UP + I_O;
    for (int it = gw; it < NITEMS; it += NGW) {
        int r = it;
        if (r < I_IN) { p0_transpose_item<0>(F.w_in, DM, NIN, ZLD, F.WinT, scr, r, F.lane); continue; } r -= I_IN;
        if (r < I_KV) { p0_transpose_item<1>(F.w_kv, DM, 2048, 2048, F.WkvT, scr, r, F.lane); continue; } r -= I_KV;
        if (r < I_UP) { p0_transpose_item<1>(F.w_up[0], 1024, DM, DM, F.WupT, scr, r, F.lane); continue; } r -= I_UP;
        if (r < I_UP) { p0_transpose_item<1>(F.w_up[1], 1024, DM, DM, F.WupT + (size_t)DM * 1024, scr, r, F.lane); continue; } r -= I_UP;
        if (r < I_UP) { p0_transpose_item<1>(F.w_up[2], 1024, DM, DM, F.WupT + (size_t)2 * DM * 1024, scr, r, F.lane); continue; } r -= I_UP;
        p0_transpose_item<1>(F.w_o, DM, DM, DM, F.WoT, scr, r, F.lane);
    }
    for (int m = gw; m < MTOK + MROWS; m += NGW) {
        if (m < MTOK) rms_row_to_bf16(F.x + (size_t)m * DM, F.pre_w, F.Hb + (size_t)m * DM, 1e-6f, F.lane);
        else rms_row_to_bf16(F.mem + (size_t)(m - MTOK) * DM, F.memn_w, F.MemN + (size_t)(m - MTOK) * DM, 1e-6f, F.lane);
    }
}

template <class Epi> DI void simple_gemm(Frame& F, const bf16* A, int lda, const bf16* Bt, int ldb, int M, int N, int K, const Epi& E) {
    const int wr = F.wave >> 2, wc = F.wave & 3, fr = F.lane & 15, fq = F.lane >> 4;
    const int ntn = N / 128, ntiles = (M / 128) * ntn;
    for (int t = blockIdx.x; t < ntiles; t += F.G) {
        const int tm = t / ntn, tn = t % ntn;
        const int row0 = tm * 128 + wr * 64, col0 = tn * 128 + wc * 32;
        f32x4 acc[4][2];
#pragma unroll
        for (int m = 0; m < 4; ++m)
#pragma unroll
            for (int n = 0; n < 2; ++n) acc[m][n] = (f32x4){0.f, 0.f, 0.f, 0.f};
        const bf16* ap = A + (size_t)(row0 + fr) * lda + 8 * fq;
        const bf16* bp = Bt + (size_t)(col0 + fr) * ldb + 8 * fq;
        for (int k0 = 0; k0 < K; k0 += 32) {
            bf16x8 a[4], b[2];
#pragma unroll
            for (int m = 0; m < 4; ++m) a[m] = *(const bf16x8*)(ap + (size_t)(16 * m) * lda + k0);
#pragma unroll
            for (int n = 0; n < 2; ++n) b[n] = *(const bf16x8*)(bp + (size_t)(16 * n) * ldb + k0);
#pragma unroll
            for (int m = 0; m < 4; ++m)
#pragma unroll
                for (int n = 0; n < 2; ++n) acc[m][n] = __builtin_amdgcn_mfma_f32_16x16x32_bf16(b[n], a[m], acc[m][n], 0, 0, 0);
        }
#pragma unroll
        for (int m = 0; m < 4; ++m)
#pragma unroll
            for (int n = 0; n < 2; ++n) E(row0 + 16 * m + fr, col0 + 16 * n + 4 * fq, acc[m][n]);
    }
}
struct EpiBf16Store { bf16* O; int ld;
    DI void operator()(int row, int col, f32x4 v) const { u32x2 o; o.x = pk2(v.x, v.y); o.y = pk2(v.z, v.w); *(u32x2*)(O + (size_t)row * ld + col) = o; } };
template <int MODE> struct EpiGate { const bf16* G; float* Mrg; bf16* Out;
    DI void operator()(int row, int col, f32x4 v) const {
        const u32x2 g = *(const u32x2*)(G + (size_t)row * ZLD + col);
        f32x4 r; r.x = sigmoid_f(bflo(g.x)) * v.x; r.y = sigmoid_f(bfhi(g.x)) * v.y; r.z = sigmoid_f(bflo(g.y)) * v.z; r.w = sigmoid_f(bfhi(g.y)) * v.w;
        float* mp = Mrg + (size_t)row * DM + col;
        if (MODE >= 1) r = r + *(const f32x4*)mp;
        if (MODE <= 1) *(f32x4*)mp = r;
        else { u32x2 o; o.x = pk2(r.x, r.y); o.y = pk2(r.z, r.w); *(u32x2*)(Out + (size_t)row * DM + col) = o; }
    } };
struct EpiF32Store { float* O; int ld;
    DI void operator()(int row, int col, f32x4 v) const { *(f32x4*)(O + (size_t)row * ld + col) = v; } };

DI unsigned okey(float f) { const unsigned u = __builtin_bit_cast(unsigned, f); return (u & 0x80000000u) ? ~u : (u | 0x80000000u); }

DI void p_indexer_naive(Frame& F) {
    LAS float* qf = (LAS float*)F.lds;
    LAS float* wf = qf + 1024;
    LAS float* sc = qf + 1024 + 64;
    LAS int* red = (LAS int*)(sc + 2048);
    const int tid = F.tid;
    for (int t = blockIdx.x; t < MTOK; t += F.G) {
        const int b = t / SEQ, i = t % SEQ;
        const bf16* zrow = F.Z + (size_t)t * ZLD;
        for (int e = tid; e < 1024; e += NTHR) qf[e] = bf2f(zrow[ZC_IQ + e]);
        if (tid < 16) wf[tid] = bf2f(zrow[ZC_IW + tid]);
        __syncthreads();
        for (int s = tid; s <= i; s += NTHR) {
            const u32x4* kp = (const u32x4*)(F.Z + (size_t)(b * SEQ + s) * ZLD + ZC_IK);
            float kf[64];
#pragma unroll
            for (int c = 0; c < 8; ++c) { const u32x4 w = kp[c];
                kf[8 * c + 0] = bflo(w.x); kf[8 * c + 1] = bfhi(w.x); kf[8 * c + 2] = bflo(w.y); kf[8 * c + 3] = bfhi(w.y);
                kf[8 * c + 4] = bflo(w.z); kf[8 * c + 5] = bfhi(w.z); kf[8 * c + 6] = bflo(w.w); kf[8 * c + 7] = bfhi(w.w); }
            float score = 0.f;
            for (int h = 0; h < 16; ++h) { float d = 0.f;
#pragma unroll
                for (int e = 0; e < 64; ++e) d += qf[h * 64 + e] * kf[e];
                score += wf[h] * fmaxf(d, 0.f); }
            sc[s] = score;
        }
        __syncthreads();
        const int n = i + 1;
        unsigned T = 0u;
        if (n > TOPK) {
            for (int bit = 31; bit >= 0; --bit) {
                const unsigned cand = T | (1u << bit);
                int cnt = 0;
                for (int s = tid; s <= i; s += NTHR) cnt += (okey(sc[s]) >= cand) ? 1 : 0;
                cnt = wave_sum_i(cnt);
                if (F.lane == 0) red[F.wave] = cnt;
                __syncthreads();
                int tot = 0;
#pragma unroll
                for (int w = 0; w < 8; ++w) tot += red[w];
                __syncthreads();
                if (tot >= TOPK) T = cand;
            }
        }
        if (tid < 64) { unsigned w = 0u;
            for (int j = 0; j < 32; ++j) { const int s = 32 * tid + j; if (s <= i && (n <= TOPK || okey(sc[s]) >= T)) w |= (1u << j); }
            F.Mask[(size_t)t * 64 + tid] = w; }
        __syncthreads();
    }
}

DI void p_dsa_naive(Frame& F) {
    LAS int* sel = (LAS int*)F.lds;
    LAS int* cw = sel + 320;
    LAS float* lg = (LAS float*)(cw + 80);
    const int tid = F.tid, lane = F.lane, h = F.wave;
    bf16* Y = F.Yb + (size_t)MTOK * 1024;
    for (int t = blockIdx.x; t < MTOK; t += F.G) {
        const int b = t / SEQ, i = t % SEQ;
        unsigned mw = 0u;
        if (tid < 64) { mw = F.Mask[(size_t)t * 64 + tid]; cw[tid] = __popc(mw); }
        __syncthreads();
        if (tid == 0) { int run = 0; for (int k = 0; k < 64; ++k) { const int c = cw[k]; cw[k] = run; run += c; } cw[64] = run; }
        __syncthreads();
        if (tid < 64) { int o = cw[tid]; unsigned w = mw; while (w) { const int j = __ffs(w) - 1; w &= w - 1u; if (o < 320) sel[o] = 32 * tid + j; ++o; } }
        __syncthreads();
        const int nsel = cw[64] < 320 ? cw[64] : 320;
        const bf16* zrow = F.Z + (size_t)t * ZLD;
        const unsigned qw = *(const unsigned*)(zrow + ZC_AQ + h * 128 + 2 * lane);
        const float q0 = bflo(qw), q1 = bfhi(qw);
        const float slope = exp2f(-(float)(h + 1));
        float mx = -1e30f;
        for (int idx = 0; idx < nsel; ++idx) {
            const int j = sel[idx];
            const unsigned kw = *(const unsigned*)(F.Z + (size_t)(b * SEQ + j) * ZLD + ZC_AK + h * 128 + 2 * lane);
            const float d = wave_sum(q0 * bflo(kw) + q1 * bfhi(kw));
            const float l = d - slope * (float)(i - j);
            if (lane == 0) lg[h * 320 + idx] = l;
            mx = fmaxf(mx, l);
        }
        float sum = 0.f;
        for (int idx = lane; idx < nsel; idx += 64) sum += __expf(lg[h * 320 + idx] - mx);
        sum = wave_sum(sum);
        const float inv = 1.f / sum;
        float a0 = 0.f, a1 = 0.f;
        for (int idx = 0; idx < nsel; ++idx) {
            const int j = sel[idx];
            const float p = __expf(lg[h * 320 + idx] - mx) * inv;
            const unsigned vw = *(const unsigned*)(F.Z + (size_t)(b * SEQ + j) * ZLD + ZC_AV + h * 128 + 2 * lane);
            a0 += p * bflo(vw); a1 += p * bfhi(vw);
        }
        const unsigned gw = *(const unsigned*)(zrow + ZC_AG + h * 128 + 2 * lane);
        *(unsigned*)(Y + (size_t)t * 1024 + h * 128 + 2 * lane) = pk2(silu_f(bflo(gw)) * a0, silu_f(bfhi(gw)) * a1);
        __syncthreads();
    }
}

DI void p_ret_naive(Frame& F) {
    const int lane = F.lane, h = F.wave;
    const float log_g = log1pf(-exp2f(-5.f - (float)h));
    for (int t = blockIdx.x; t < MTOK; t += F.G) {
        const int b = t / SEQ, i = t % SEQ;
        const bf16* zrow = F.Z + (size_t)t * ZLD;
        const unsigned qw = *(const unsigned*)(zrow + ZC_RQ + h * 128 + 2 * lane);
        const float q0 = bflo(qw), q1 = bfhi(qw);
        float a0 = 0.f, a1 = 0.f;
        for (int j = 0; j <= i; ++j) {
            const bf16* kr = F.Z + (size_t)(b * SEQ + j) * ZLD;
            const unsigned kw = *(const unsigned*)(kr + ZC_RK + h * 128 + 2 * lane);
            const unsigned vw = *(const unsigned*)(kr + ZC_RV + h * 128 + 2 * lane);
            const float d = wave_sum(q0 * bflo(kw) + q1 * bfhi(kw)) * __expf(log_g * (float)(i - j));
            a0 += d * bflo(vw); a1 += d * bfhi(vw);
        }
        const float mean = wave_sum(a0 + a1) * (1.f / 128.f);
        const float d0 = a0 - mean, d1 = a1 - mean;
        const float var = wave_sum(d0 * d0 + d1 * d1) * (1.f / 128.f);
        const float rs = 1.0f / sqrtf(var + 1e-5f);
        const float w0 = F.gn_w[h * 128 + 2 * lane], w1 = F.gn_w[h * 128 + 2 * lane + 1];
        const unsigned gw = *(const unsigned*)(zrow + ZC_RG + h * 128 + 2 * lane);
        *(unsigned*)(F.Yb + (size_t)t * 1024 + h * 128 + 2 * lane) = pk2(silu_f(bflo(gw)) * d0 * rs * w0, silu_f(bfhi(gw)) * d1 * rs * w1);
    }
}

DI void p_mem_naive(Frame& F) {
    LAS float* lg = (LAS float*)F.lds;
    const int lane = F.lane, w = F.wave, hh = w & 3;
    bf16* Y = F.Yb + (size_t)2 * MTOK * 1024;
    for (int t2 = blockIdx.x; t2 < MTOK / 2; t2 += F.G) {
        const int t = 2 * t2 + (w >> 2), b = t / SEQ;
        const bf16* zrow = F.Z + (size_t)t * ZLD;
        const u32x2 qw = *(const u32x2*)(zrow + ZC_MQ + hh * 256 + 4 * lane);
        const float q0 = bflo(qw.x), q1 = bfhi(qw.x), q2 = bflo(qw.y), q3 = bfhi(qw.y);
        float mx = -1e30f;
        for (int m = 0; m < MEMT; ++m) {
            const u32x2 kw = *(const u32x2*)(F.KVm + (size_t)(b * MEMT + m) * 2048 + hh * 256 + 4 * lane);
            const float d = wave_sum(q0 * bflo(kw.x) + q1 * bfhi(kw.x) + q2 * bflo(kw.y) + q3 * bfhi(kw.y));
            if (lane == 0) lg[w * 256 + m] = d;
            mx = fmaxf(mx, d);
        }
        float sum = 0.f;
        for (int m = lane; m < MEMT; m += 64) sum += __expf(lg[w * 256 + m] - mx);
        sum = wave_sum(sum);
        const float inv = 1.f / sum;
        float a0 = 0.f, a1 = 0.f, a2 = 0.f, a3 = 0.f;
        for (int m = 0; m < MEMT; ++m) {
            const float p = __expf(lg[w * 256 + m] - mx) * inv;
            const u32x2 vw = *(const u32x2*)(F.KVm + (size_t)(b * MEMT + m) * 2048 + 1024 + hh * 256 + 4 * lane);
            a0 += p * bflo(vw.x); a1 += p * bfhi(vw.x); a2 += p * bflo(vw.y); a3 += p * bfhi(vw.y);
        }
        const u32x2 gw = *(const u32x2*)(zrow + ZC_MG + hh * 256 + 4 * lane);
        u32x2 o; o.x = pk2(silu_f(bflo(gw.x)) * a0, silu_f(bfhi(gw.x)) * a1); o.y = pk2(silu_f(bflo(gw.y)) * a2, silu_f(bfhi(gw.y)) * a3);
        *(u32x2*)(Y + (size_t)t * 1024 + hh * 256 + 4 * lane) = o;
    }
}

DI void p_final(Frame& F) {
    const int gw = blockIdx.x * NWAVES + F.wave, NGW = F.G * NWAVES, lane = F.lane;
    for (int m = gw; m < MTOK; m += NGW) {
        f32x4* orow = (f32x4*)(F.out + (size_t)m * DM) + lane; const f32x4* xr = (const f32x4*)(F.x + (size_t)m * DM) + lane; const f32x4* wr = (const f32x4*)F.post_w + lane;
        f32x4 v[8]; float s = 0.f;
#pragma unroll
        for (int j = 0; j < 8; ++j) { v[j] = orow[64 * j]; s += (v[j].x * v[j].x + v[j].y * v[j].y) + (v[j].z * v[j].z + v[j].w * v[j].w); }
        const float r = 1.0f / sqrtf(wave_sum(s) * (1.f / DM) + 1e-6f);
#pragma unroll
        for (int j = 0; j < 8; ++j) orow[64 * j] = xr[64 * j] + v[j] * r * wr[64 * j];
    }
}

constexpr int N_PHASES = 11;
struct Args { const float* in[12]; float* out; unsigned char* ws; int ph_lo, ph_hi; };
__global__ void __launch_bounds__(NTHR, 2) layer_fwd(Args args) {
    extern __shared__ __attribute__((aligned(16))) unsigned char lds[];
    Frame F;
    F.lds = (LAS unsigned char*)lds;
    F.tid = threadIdx.x; F.lane = F.tid & 63; F.wave = __builtin_amdgcn_readfirstlane(F.tid >> 6); F.G = gridDim.x;
    unsigned char* ws = args.ws;
    F.x = args.in[0]; F.mem = args.in[1]; F.pre_w = args.in[2]; F.w_in = args.in[3]; F.gn_w = args.in[4]; F.memn_w = args.in[5]; F.w_kv = args.in[6];
    F.w_up[0] = args.in[7]; F.w_up[1] = args.in[8]; F.w_up[2] = args.in[9]; F.w_o = args.in[10]; F.post_w = args.in[11]; F.out = args.out;
    F.WinT = (bf16*)(ws + WS_WINT); F.WkvT = (bf16*)(ws + WS_WKVT); F.WupT = (bf16*)(ws + WS_WUPT); F.WoT = (bf16*)(ws + WS_WOT);
    F.Hb = (bf16*)(ws + WS_HB); F.MemN = (bf16*)(ws + WS_MEMN); F.KVm = (bf16*)(ws + WS_KVM); F.Yb = (bf16*)(ws + WS_YB); F.Z = (bf16*)(ws + WS_Z);
    F.Merged = (bf16*)(ws + WS_MERGED); F.Mrg = (float*)(ws + WS_MRG); F.Mask = (unsigned*)(ws + WS_MASK);
    volatile LAS unsigned* MISC = (volatile LAS unsigned*)(F.lds + MISC_OFF);
    if (F.tid < 32) MISC[F.tid] = 0u;
    __syncthreads();
    const int lo = args.ph_lo, hi = args.ph_hi;
    const bool one = (hi - lo) > 1;
    XcdBarrier bar; bar.bar = (unsigned*)(ws + WS_CTL) + CW_BAR; bar.x = 0; bar.st = nullptr;
    if (one) bar = xcd_barrier_post((unsigned*)(ws + WS_CTL) + CW_BAR, MISC + 8);
#define IN(k) (lo <= (k) && (k) < hi)
#define SEAM(k) do { if (IN(k) && IN((k) + 1)) xcd_barrier(bar); } while (0)
    if (IN(0)) { p0_prologue(F); } SEAM(0);
    if (IN(1)) { EpiBf16Store E{F.Z, ZLD}; simple_gemm(F, F.Hb, DM, F.WinT, DM, MTOK, ZLD, DM, E);
                 EpiBf16Store E2{F.KVm, 2048}; simple_gemm(F, F.MemN, DM, F.WkvT, DM, MROWS, 2048, DM, E2); } SEAM(1);
    if (IN(2)) { p_indexer_naive(F); } SEAM(2);
    if (IN(3)) { p_dsa_naive(F); } SEAM(3);
    if (IN(4)) { p_ret_naive(F); } SEAM(4);
    if (IN(5)) { p_mem_naive(F); } SEAM(5);
    if (IN(6)) { EpiGate<0> E{F.Z + ZC_GR, F.Mrg, F.Merged}; simple_gemm(F, F.Yb, 1024, F.WupT, 1024, MTOK, DM, 1024, E); } SEAM(6);
    if (IN(7)) { EpiGate<1> E{F.Z + ZC_GD, F.Mrg, F.Merged}; simple_gemm(F, F.Yb + (size_t)MTOK * 1024, 1024, F.WupT + (size_t)DM * 1024, 1024, MTOK, DM, 1024, E); } SEAM(7);
    if (IN(8)) { EpiGate<2> E{F.Z + ZC_GM, F.Mrg, F.Merged}; simple_gemm(F, F.Yb + (size_t)2 * MTOK * 1024, 1024, F.WupT + (size_t)2 * DM * 1024, 1024, MTOK, DM, 1024, E); } SEAM(8);
    if (IN(9)) { EpiF32Store E{F.out, DM}; simple_gemm(F, F.Merged, DM, F.WoT, DM, MTOK, DM, DM, E); } SEAM(9);
    if (IN(10)) { p_final(F); }
#undef IN
#undef SEAM
}

extern "C" void kernel_launch(void* const* d_in, const int* in_sizes, int n_in, void* d_out, int out_size, void* d_ws, size_t ws_size, hipStream_t stream) {
    static int grid = 0;
    if (grid == 0) {
        if (n_in != 12 || out_size != MTOK * DM || ws_size < WS_END) { fprintf(stderr, "kernel_launch: unexpected problem (n_in %d, out %d, ws %zu)\n", n_in, out_size, ws_size); grid = -1; return; }
        int dev = 0, cus = 0;
        if (hipGetDevice(&dev) != hipSuccess || hipDeviceGetAttribute(&cus, hipDeviceAttributeMultiprocessorCount, dev) != hipSuccess) { grid = -1; return; }
        if (hipFuncSetAttribute((const void*)layer_fwd, hipFuncAttributeMaxDynamicSharedMemorySize, LDS_BYTES) != hipSuccess) { fprintf(stderr, "kernel_launch: hipFuncSetAttribute failed\n"); grid = -1; return; }
        int per_cu = 0;
        if (hipOccupancyMaxActiveBlocksPerMultiprocessor(&per_cu, (const void*)layer_fwd, NTHR, LDS_BYTES) != hipSuccess || per_cu < 1) fprintf(stderr, "kernel_launch: occupancy query reports %d\n", per_cu);
        (void)hipGetLastError();
        grid = cus;
    }
    if (grid < 0) return;
    (void)hipMemsetAsync((char*)d_ws + WS_CTL, 0, CTL_ZERO_BYTES, stream);
    Args a{};
    for (int i = 0; i < 12; ++i) a.in[i] = (const float*)d_in[i];
    a.out = (float*)d_out; a.ws = (unsigned char*)d_ws;
#if MK_N_LAUNCHES == 1
    a.ph_lo = 0; a.ph_hi = N_PHASES;
    hipLaunchKernelGGL(layer_fwd, dim3(grid), dim3(NTHR), LDS_BYTES, stream, a);
#else
    for (int p = 0; p < N_PHASES; ++p) { a.ph_lo = p; a.ph_hi = p + 1; hipLaunchKernelGGL(layer_fwd, dim3(grid), dim3(NTHR), LDS_BYTES, stream, a); }
#endif
}
```

```cpp
#include <hip/hip_runtime.h>
#include <cstdio>
#include <cstdint>

#ifndef MK_N_LAUNCHES
#define MK_N_LAUNCHES 1
#endif

#define GAS __attribute__((address_space(1)))
#define LAS __attribute__((address_space(3)))
typedef unsigned short bf16;
typedef short bf16x8 __attribute__((ext_vector_type(8)));
typedef float f32x4 __attribute__((ext_vector_type(4)));
typedef unsigned u32x4 __attribute__((ext_vector_type(4)));
typedef unsigned u32x2 __attribute__((ext_vector_type(2)));
typedef GAS unsigned gu32;
#define RLX_AGENT __ATOMIC_RELAXED, __HIP_MEMORY_SCOPE_AGENT
#define DI __device__ __forceinline__

constexpr int NB = 4, SEQ = 2048, DM = 2048, MTOK = NB * SEQ;
constexpr int NIN = 17488, ZLD = 17664;
constexpr int MEMT = 256, MROWS = NB * MEMT;
constexpr int ZC_RQ = 0, ZC_RK = 1024, ZC_RV = 2048, ZC_RG = 3072, ZC_AQ = 4096, ZC_AK = 5120, ZC_AV = 6144, ZC_AG = 7168,
              ZC_IQ = 8192, ZC_IK = 9216, ZC_IW = 9280, ZC_PAD = 9296, ZC_MQ = 9472, ZC_MG = 10496, ZC_GR = 11520, ZC_GD = 13568, ZC_GM = 15616;
constexpr int TOPK = 256;

constexpr size_t MiB = 1u << 20;
constexpr size_t WS_CTL = 0, CTL_ZERO_BYTES = 1 * MiB;
constexpr size_t WS_WINT = 1 * MiB;
constexpr size_t WS_MRG = 1 * MiB;
constexpr size_t WS_WKVT = 70 * MiB;
constexpr size_t WS_WUPT = 78 * MiB;
constexpr size_t WS_WOT = 90 * MiB;
constexpr size_t WS_HB = 98 * MiB;
constexpr size_t WS_MERGED = 98 * MiB;
constexpr size_t WS_MEMN = 130 * MiB;
constexpr size_t WS_KVM = 134 * MiB;
constexpr size_t WS_MASK = 138 * MiB;
constexpr size_t WS_YB = 141 * MiB;
constexpr size_t WS_Z = 189 * MiB;
constexpr size_t WS_END = 465 * MiB;
static_assert(WS_WINT + (size_t)ZLD * DM * 2 <= WS_WKVT && WS_Z + (size_t)MTOK * ZLD * 2 <= WS_END, "ws map");

constexpr int CW_BAR = 4096;

constexpr int NWAVES = 8, NTHR = 512;
constexpr int LDS_BYTES = 147456;
constexpr int MISC_OFF = 139264;

DI unsigned f2bf(float f) { unsigned u = __builtin_bit_cast(unsigned, f); return (u + 0x7fffu + ((u >> 16) & 1u)) >> 16; }
DI unsigned pk2(float lo, float hi) { return f2bf(lo) | (f2bf(hi) << 16); }
DI float bf2f(unsigned h) { return __builtin_bit_cast(float, h << 16); }
DI float bflo(unsigned w) { return __builtin_bit_cast(float, w << 16); }
DI float bfhi(unsigned w) { return __builtin_bit_cast(float, w & 0xffff0000u); }
DI float wave_sum(float v) {
#pragma unroll
    for (int o = 1; o < 64; o <<= 1) v += __shfl_xor(v, o);
    return v;
}
DI int wave_sum_i(int v) {
#pragma unroll
    for (int o = 1; o < 64; o <<= 1) v += __shfl_xor(v, o);
    return v;
}
DI float wave_max(float v) {
#pragma unroll
    for (int o = 1; o < 64; o <<= 1) v = fmaxf(v, __shfl_xor(v, o));
    return v;
}
DI float silu_f(float x) { return x / (1.f + __expf(-x)); }
DI float sigmoid_f(float x) { return 1.f / (1.f + __expf(-x)); }

#define XB_TMO      128
#define XB_XCNT(j)  (256  + 64 * (j))
#define XB_XSUB(j)  (1280 + 64 * (j))
#define XB_XGEN(j)  (2304 + 64 * (j))
#define XB_TOP      3328
#define XB_TOPGEN   3392
#define XCD_BAR_WORDS 3456
#define XB_SPIN_CAP (1u << 22)
DI unsigned xb_ld(unsigned* p)              { return __hip_atomic_load(p, __ATOMIC_RELAXED, __HIP_MEMORY_SCOPE_AGENT); }
DI unsigned xb_add(unsigned* p, unsigned v) { return __hip_atomic_fetch_add(p, v, __ATOMIC_RELAXED, __HIP_MEMORY_SCOPE_AGENT); }
DI unsigned xb_xcc_id() { return (unsigned)__builtin_amdgcn_s_getreg((3 << 11) | 20) & 0xFu; }
#define XB_SPIN(cond, bar) do { unsigned _sp = 0; while (cond) { __builtin_amdgcn_s_sleep(1); \
    if ((++_sp & 255u) == 0u) { if (xb_ld(&(bar)[XB_TMO])) break; if (_sp > XB_SPIN_CAP) { atomicAdd(&(bar)[XB_TMO], 1u); break; } } } } while (0)
struct XcdBarrier { unsigned* bar; unsigned x; volatile LAS unsigned* st; };
DI XcdBarrier xcd_barrier_post(unsigned* bar, volatile LAS unsigned* st) {
    XcdBarrier b; b.bar = bar; b.x = xb_xcc_id(); b.st = st;
    if (threadIdx.x == 0) (void)xb_add(&bar[XB_XCNT(b.x)], 1u);
    return b;
}
DI void xcd_barrier_complete(unsigned* bar, unsigned x, unsigned& nloc, unsigned& nx) {
    const unsigned G = gridDim.x * gridDim.y * gridDim.z;
    unsigned sum, cnt, mine, sp = 0u;
    for (;;) {
        sum = 0u; cnt = 0u; mine = 0u;
#pragma unroll
        for (unsigned j = 0; j < 16; ++j) { const unsigned c = xb_ld(&bar[XB_XCNT(j)]); sum += c; cnt += (c > 0u) ? 1u : 0u; mine = (j == x) ? c : mine; }
        if (sum == G) break;
        __builtin_amdgcn_s_sleep(1);
        if ((++sp & 255u) == 0u) { if (xb_ld(&bar[XB_TMO])) break; if (sp > XB_SPIN_CAP) { atomicAdd(&bar[XB_TMO], 1u); break; } }
    }
    nloc = mine > 0u ? mine : 1u; nx = cnt > 0u ? cnt : 1u;
}
DI void xcd_barrier(const XcdBarrier& b) {
    asm volatile("s_waitcnt vmcnt(0)" ::: "memory");
    __syncthreads();
    if (threadIdx.x == 0) {
        unsigned* bar = b.bar;
        __builtin_amdgcn_s_waitcnt(0);
        unsigned nloc = b.st[0], nx = b.st[1];
        if (nloc == 0u) { xcd_barrier_complete(bar, b.x, nloc, nx); b.st[0] = nloc; b.st[1] = nx; }
        const unsigned old = xb_add(&bar[XB_XSUB(b.x)], 1u);
        const unsigned gen = old / nloc;
        if (old + 1u == (gen + 1u) * nloc) {
            __builtin_amdgcn_fence(__ATOMIC_RELEASE, "agent");
            asm volatile("s_waitcnt vmcnt(0)" ::: "memory");
            const unsigned og = xb_add(&bar[XB_TOP], 1u);
            const unsigned tg = og / nx;
            if (og + 1u == (tg + 1u) * nx) xb_add(&bar[XB_TOPGEN], 1u);
            else XB_SPIN(xb_ld(&bar[XB_TOPGEN]) == tg, bar);
            __builtin_amdgcn_fence(__ATOMIC_ACQUIRE, "agent");
            xb_add(&bar[XB_XGEN(b.x)], 1u);
            asm volatile("s_waitcnt vmcnt(0)" ::: "memory");
        } else {
            XB_SPIN(xb_ld(&bar[XB_XGEN(b.x)]) == gen, bar);
            __builtin_amdgcn_fence(__ATOMIC_ACQUIRE, "agent");
            asm volatile("s_waitcnt vmcnt(0)" ::: "memory");
        }
    }
    __syncthreads();
}

struct Frame {
    LAS unsigned char* lds;
    int tid, lane, wave, G;
    const float *x, *mem, *pre_w, *w_in, *gn_w, *memn_w, *w_kv, *w_up[3], *w_o, *post_w;
    float* out;
    bf16 *WinT, *WkvT, *WupT, *WoT, *Hb, *MemN, *KVm, *Yb, *Z, *Merged;
    float* Mrg;
    unsigned* Mask;
};

template <int KIND> DI int src_col(int n) { if (KIND == 0) return n < ZC_PAD ? n : (n < ZC_MQ ? -1 : n - (ZC_MQ - ZC_PAD)); return n; }
template <int KIND> DI float src_scale(int n) {
    if (KIND == 0) {
        if ((n >= ZC_RK && n < ZC_RV) || (n >= ZC_AQ && n < ZC_AK)) return 0.08838834764831845f;
        if (n >= ZC_IQ && n < ZC_IK) return 0.125f;
        if (n >= ZC_IW && n < ZC_PAD) return 0.25f;
        if (n >= ZC_MQ && n < ZC_MG) return 0.0625f;
    }
    return 1.f;
}
template <int KIND> DI void p0_transpose_item(const float* W, int K, int Nsrc, int Ndst, bf16* WT, LAS float* scr, int item, int lane) {
    const int nblk = Ndst / 64, kb = item / nblk, nb = item % nblk, k0 = 64 * kb, n0 = 64 * nb;
    const int sc = src_col<KIND>(n0 + lane); const float s = src_scale<KIND>(n0 + lane);
    const float* src = W + (size_t)k0 * Nsrc + (sc < 0 ? 0 : sc);
#pragma unroll 8
    for (int i = 0; i < 64; ++i) { const float v = src[(size_t)i * Nsrc]; scr[i * 65 + lane] = sc < 0 ? 0.f : v * s; }
    asm volatile("s_waitcnt lgkmcnt(0)" ::: "memory");
    const int c = lane & 7;
#pragma unroll
    for (int j = 0; j < 8; ++j) { const int n = (lane >> 3) + 8 * j; const LAS float* p = scr + (8 * c) * 65 + n;
        u32x4 o; o.x = pk2(p[0 * 65], p[1 * 65]); o.y = pk2(p[2 * 65], p[3 * 65]); o.z = pk2(p[4 * 65], p[5 * 65]); o.w = pk2(p[6 * 65], p[7 * 65]);
        *(u32x4*)(WT + (size_t)(n0 + n) * K + k0 + 8 * c) = o; }
    asm volatile("s_waitcnt lgkmcnt(0)" ::: "memory");
}
DI void rms_row_to_bf16(const float* xrow, const float* w, bf16* orow, float eps, int lane) {
    const f32x4* xr = (const f32x4*)xrow + lane; const f32x4* wr = (const f32x4*)w + lane;
    f32x4 v[8]; float s = 0.f;
#pragma unroll
    for (int j = 0; j < 8; ++j) { v[j] = xr[64 * j]; s += (v[j].x * v[j].x + v[j].y * v[j].y) + (v[j].z * v[j].z + v[j].w * v[j].w); }
    const float r = 1.0f / sqrtf(wave_sum(s) * (1.f / DM) + eps);
    u32x2* o8 = (u32x2*)orow + lane;
#pragma unroll
    for (int j = 0; j < 8; ++j) { const f32x4 ww = wr[64 * j]; u32x2 o; o.x = pk2(v[j].x * r * ww.x, v[j].y * r * ww.y); o.y = pk2(v[j].z * r * ww.z, v[j].w * r * ww.w); o8[64 * j] = o; }
}
DI void p0_prologue(Frame& F) {
    LAS float* scr = (LAS float*)(F.lds + F.wave * 16640);
    const int gw = blockIdx.x * NWAVES + F.wave, NGW = F.G * NWAVES;
    constexpr int I_IN = (DM / 64) * (ZLD / 64), I_KV = (DM / 64) * (2048 / 64), I_UP = (1024 / 64) * (DM / 64), I_O = (DM / 64) * (DM / 64);
    constexpr int NITEMS = I_IN + I_KV + 3 * I_UP + I_O;
    for (int it = gw; it < NITEMS; it += NGW) {
        int r = it;
        if (r < I_IN) { p0_transpose_item<0>(F.w_in, DM, NIN, ZLD, F.WinT, scr, r, F.lane); continue; } r -= I_IN;
        if (r < I_KV) { p0_transpose_item<1>(F.w_kv, DM, 2048, 2048, F.WkvT, scr, r, F.lane); continue; } r -= I_KV;
        if (r < I_UP) { p0_transpose_item<1>(F.w_up[0], 1024, DM, DM, F.WupT, scr, r, F.lane); continue; } r -= I_UP;
        if (r < I_UP) { p0_transpose_item<1>(F.w_up[1], 1024, DM, DM, F.WupT + (size_t)DM * 1024, scr, r, F.lane); continue; } r -= I_UP;
        if (r < I_UP) { p0_transpose_item<1>(F.w_up[2], 1024, DM, DM, F.WupT + (size_t)2 * DM * 1024, scr, r, F.lane); continue; } r -= I_UP;
        p0_transpose_item<1>(F.w_o, DM, DM, DM, F.WoT, scr, r, F.lane);
    }
    for (int m = gw; m < MTOK + MROWS; m += NGW) {
        if (m < MTOK) rms_row_to_bf16(F.x + (size_t)m * DM, F.pre_w, F.Hb + (size_t)m * DM, 1e-6f, F.lane);
        else rms_row_to_bf16(F.mem + (size_t)(m - MTOK) * DM, F.memn_w, F.MemN + (size_t)(m - MTOK) * DM, 1e-6f, F.lane);
    }
}


namespace pg8 {
#define PG8_LAS __attribute__((address_space(3)))
constexpr int BM = 256, BK = 64, HALF = 128, HTB = HALF * BK * 2, STAGE_BYTES = 8 * HTB, NXCD = 8, WGM = 8;
DI int lds_byte(int r, int c) { const int st = (r >> 4) * 2 + (c >> 5), rr = r & 15, cc = c & 31, ob = rr * 64 + cc * 2; return st * 1024 + (ob ^ (((ob >> 9) & 1) << 5)); }
DI void stage_rc(int b, int& R, int& C) { const int st = b / 1024, sb = b % 1024, swz = sb ^ (((sb >> 9) & 1) << 5); R = (st >> 1) * 16 + swz / 64; C = (st & 1) * 32 + (swz % 64) / 2; }
DI int perm32(int rho) { const int n = rho >> 4, i = rho & 15; return 8 * (i >> 2) + 4 * n + (i & 3); }
struct Unit { int pm, pn, w; };
struct GemmG { int lda, ldb, K; };
DI unsigned cvt_pk_bf16(float lo, float hi) { unsigned r; asm volatile("v_cvt_pk_bf16_f32 %0, %1, %2" : "=v"(r) : "v"(lo), "v"(hi)); return r; }
template <class Epi, class Sched, bool ALIGN_EPI = false, bool SP2 = false>
__device__ __forceinline__ void gemm_phase(PG8_LAS unsigned char* lds, const GemmG g, const Sched& S, const Epi& E) {
    const int tid = threadIdx.x, wid = __builtin_amdgcn_readfirstlane(tid >> 6), lane = tid & 63, wr = wid >> 2, wc = wid & 3, fr = lane & 15, fq = lane >> 4;
    const int K = g.K, nt = K / BK;
    unsigned voffA[2], voffB[2];
#pragma unroll
    for (int i = 0; i < 2; ++i) { int R, C; stage_rc(tid * 16 + i * 8192, R, C); const int Rb = Epi::PERM ? ((R & ~31) + perm32(R & 31)) : R;
        voffA[i] = (unsigned)(R * g.lda + C) * 2u; voffB[i] = (unsigned)(Rb * g.ldb + C) * 2u; }
    const size_t kstep = (size_t)(BK * 2);
    const size_t hstepA = (size_t)HALF * g.lda * 2, hstepB = (size_t)HALF * g.ldb * 2;
    const unsigned ldsw = (unsigned)wid * 1024u;
    const int aoff = lds_byte(wr * 64 + fr, fq * 8), boff = lds_byte(wc * 32 + fr, fq * 8);
#define PG8_SA(b, h) (((b) * 2 + (h)) * HTB)
#define PG8_SB(b, h) ((4 + (b) * 2 + (h)) * HTB)
#define PG8_STAGE(bufoff, gbase, voff) do { _Pragma("unroll") for (int _i = 0; _i < 2; ++_i) \
        __builtin_amdgcn_global_load_lds((const unsigned*)((const char*)(gbase) + (voff)[_i]), (PG8_LAS unsigned*)(lds + (bufoff) + ldsw + _i * 8192), 16, 0, 0); } while (0)
#define PG8_LDA(dst, b, h) do { _Pragma("unroll") for (int m = 0; m < 4; ++m) _Pragma("unroll") for (int k = 0; k < 2; ++k) dst[m][k] = *(const PG8_LAS bf16x8*)(lds + PG8_SA(b, h) + aoff + m * 2048 + k * 1024); } while (0)
#define PG8_LDB(dst, b, h) do { _Pragma("unroll") for (int n = 0; n < 2; ++n) _Pragma("unroll") for (int k = 0; k < 2; ++k) dst[n][k] = *(const PG8_LAS bf16x8*)(lds + PG8_SB(b, h) + boff + n * 2048 + k * 1024); } while (0)
#define PG8_MMA(ai, bj, At, Bt) do { __builtin_amdgcn_s_setprio(1); _Pragma("unroll") for (int m = 0; m < 4; ++m) _Pragma("unroll") for (int n = 0; n < 2; ++n) _Pragma("unroll") for (int k = 0; k < 2; ++k) \
        acc[ai][bj][m][n] = __builtin_amdgcn_mfma_f32_16x16x32_bf16(Bt[n][k], At[m][k], acc[ai][bj][m][n], 0, 0, 0); __builtin_amdgcn_s_setprio(0); } while (0)
#define PG8_WAIT_V(n) asm volatile("s_waitcnt vmcnt(" #n ")" ::: "memory")
#define PG8_WAIT_L(n) asm volatile("s_waitcnt lgkmcnt(" #n ")" ::: "memory")
#define PG8_BAR __builtin_amdgcn_s_barrier()
#define PG8_SCHED __builtin_amdgcn_sched_barrier(0)
    Unit cur, nxt; int ui = 0;
    if (!S.next(0, cur)) return;
    f32x4 acc[2][2][4][2];
#pragma unroll
    for (int a = 0; a < 2; ++a)
#pragma unroll
        for (int b = 0; b < 2; ++b)
#pragma unroll
            for (int m = 0; m < 4; ++m)
#pragma unroll
                for (int n = 0; n < 2; ++n) acc[a][b][m][n] = (f32x4){0.f, 0.f, 0.f, 0.f};
    bf16x8 At[4][2], B0[2][2], B1[2][2];
    const char* cA = S.a_ptr(cur); const char* cB = S.b_ptr(cur);
    S.a_ready(cur);
    if constexpr (SP2) {
        PG8_STAGE(PG8_SB(0, 0), cB, voffB); PG8_STAGE(PG8_SB(0, 1), cB + hstepB, voffB); PG8_STAGE(PG8_SA(0, 0), cA, voffA); PG8_STAGE(PG8_SA(0, 1), cA + hstepA, voffA);
        if (wr == 1) PG8_BAR;
        PG8_WAIT_V(2); PG8_BAR;
        PG8_STAGE(PG8_SB(1, 0), cB + kstep, voffB); PG8_STAGE(PG8_SA(1, 0), cA + kstep, voffA); PG8_STAGE(PG8_SB(1, 1), cB + hstepB + kstep, voffB);
        PG8_WAIT_V(6); PG8_BAR;
    } else {
        PG8_STAGE(PG8_SB(0, 0), cB, voffB); PG8_STAGE(PG8_SA(0, 0), cA, voffA); PG8_STAGE(PG8_SB(0, 1), cB + hstepB, voffB); PG8_STAGE(PG8_SA(0, 1), cA + hstepA, voffA);
        if (wr == 1) PG8_BAR;
        PG8_WAIT_V(4); PG8_BAR;
        PG8_STAGE(PG8_SB(1, 0), cB + kstep, voffB); PG8_STAGE(PG8_SA(1, 0), cA + kstep, voffA); PG8_STAGE(PG8_SB(1, 1), cB + hstepB + kstep, voffB);
        PG8_WAIT_V(6); PG8_BAR;
    }
    for (;;) {
        const bool has_next = S.next(ui + 1, nxt);
        const char* nA = has_next ? S.a_ptr(nxt) : cA; const char* nB = has_next ? S.b_ptr(nxt) : cB;
        for (int t = 0; t < nt; t += 2) {
            const bool last = (t == nt - 2);
            const char* a1 = cA + (size_t)(t + 1) * kstep;
            const char* a2 = last ? nA : cA + (size_t)(t + 2) * kstep; const char* b2 = last ? nB : cB + (size_t)(t + 2) * kstep;
            const char* a3 = a2 + kstep; const char* b3 = b2 + kstep;
            if (last && has_next) S.a_ready(nxt);
            if constexpr (SP2) {
            PG8_LDB(B0, 0, 0); PG8_LDB(B1, 0, 1); PG8_SCHED; PG8_LDA(At, 0, 0); PG8_STAGE(PG8_SA(1, 1), a1 + hstepA, voffA);
            PG8_WAIT_V(8); PG8_WAIT_L(0); PG8_BAR; PG8_MMA(0, 0, At, B0); PG8_MMA(0, 1, At, B1); PG8_BAR; PG8_SCHED;
            PG8_LDA(At, 0, 1); PG8_STAGE(PG8_SB(0, 0), b2, voffB); PG8_STAGE(PG8_SB(0, 1), b2 + hstepB, voffB); PG8_STAGE(PG8_SA(0, 0), a2, voffA);
            PG8_WAIT_V(8); PG8_WAIT_L(0); PG8_BAR; PG8_MMA(1, 0, At, B0); PG8_MMA(1, 1, At, B1); PG8_BAR; PG8_SCHED;
            PG8_LDB(B0, 1, 0); PG8_LDB(B1, 1, 1); PG8_SCHED; PG8_LDA(At, 1, 0); PG8_STAGE(PG8_SA(0, 1), a2 + hstepA, voffA);
            PG8_WAIT_V(8); PG8_WAIT_L(0); PG8_BAR; PG8_MMA(0, 0, At, B0); PG8_MMA(0, 1, At, B1); PG8_BAR; PG8_SCHED;
            PG8_LDA(At, 1, 1); PG8_STAGE(PG8_SB(1, 0), b3, voffB); PG8_STAGE(PG8_SB(1, 1), b3 + hstepB, voffB); PG8_STAGE(PG8_SA(1, 0), a3, voffA);
            PG8_WAIT_V(8); PG8_WAIT_L(0); PG8_BAR; PG8_MMA(1, 0, At, B0); PG8_MMA(1, 1, At, B1); PG8_BAR; PG8_SCHED;
            } else {
            PG8_LDB(B0, 0, 0); PG8_SCHED; PG8_LDA(At, 0, 0); PG8_STAGE(PG8_SA(1, 1), a1 + hstepA, voffA);
            PG8_WAIT_L(8); PG8_BAR; PG8_WAIT_L(0); PG8_MMA(0, 0, At, B0); PG8_BAR; PG8_SCHED;
            PG8_LDB(B1, 0, 1); PG8_STAGE(PG8_SB(0, 0), b2, voffB);
            PG8_BAR; PG8_WAIT_L(0); PG8_MMA(0, 1, At, B1); PG8_BAR;
            PG8_LDA(At, 0, 1); PG8_STAGE(PG8_SA(0, 0), a2, voffA);
            PG8_BAR; PG8_WAIT_L(0); PG8_MMA(1, 0, At, B0); PG8_BAR; PG8_SCHED;
            PG8_STAGE(PG8_SB(0, 1), b2 + hstepB, voffB);
            PG8_WAIT_V(6); PG8_BAR; PG8_MMA(1, 1, At, B1); PG8_BAR;
            PG8_LDB(B0, 1, 0); PG8_SCHED; PG8_LDA(At, 1, 0); PG8_STAGE(PG8_SA(0, 1), a2 + hstepA, voffA);
            PG8_WAIT_L(8); PG8_BAR; PG8_WAIT_L(0); PG8_MMA(0, 0, At, B0); PG8_BAR; PG8_SCHED;
            PG8_LDB(B1, 1, 1); PG8_STAGE(PG8_SB(1, 0), b3, voffB);
            PG8_BAR; PG8_WAIT_L(0); PG8_MMA(0, 1, At, B1); PG8_BAR;
            PG8_LDA(At, 1, 1); PG8_STAGE(PG8_SA(1, 0), a3, voffA);
            PG8_BAR; PG8_WAIT_L(0); PG8_MMA(1, 0, At, B0); PG8_BAR; PG8_SCHED;
            PG8_STAGE(PG8_SB(1, 1), b3 + hstepB, voffB);
            PG8_WAIT_V(6); PG8_BAR; PG8_MMA(1, 1, At, B1); PG8_BAR;
            }
        }
        if constexpr (ALIGN_EPI) { if (wr == 0) PG8_BAR; }
        if constexpr (!Epi::AFTER_DRAIN) { E(acc, cur, wr, wc, fr, fq); S.done(cur); }
        if (!has_next) break;
        if (!Epi::keep_acc(cur))
#pragma unroll
        for (int a = 0; a < 2; ++a)
#pragma unroll
            for (int b = 0; b < 2; ++b)
#pragma unroll
                for (int m = 0; m < 4; ++m)
#pragma unroll
                    for (int n = 0; n < 2; ++n) acc[a][b][m][n] = (f32x4){0.f, 0.f, 0.f, 0.f};
        cur = nxt; cA = nA; cB = nB; ++ui;
        if constexpr (ALIGN_EPI) { if (wr == 1) PG8_BAR; }
    }
    PG8_WAIT_V(0);
    if constexpr (!ALIGN_EPI) { if (wr == 0) PG8_BAR; }
    PG8_BAR;
    if constexpr (Epi::AFTER_DRAIN) { E.fused(acc, cur, wr, wc, fr, fq, lds, wid, lane); S.done(cur); }
#undef PG8_SA
#undef PG8_SB
#undef PG8_STAGE
#undef PG8_LDA
#undef PG8_LDB
#undef PG8_MMA
#undef PG8_WAIT_V
#undef PG8_WAIT_L
#undef PG8_BAR
#undef PG8_SCHED
}

}


namespace pg8 {
struct EpiZ {
    static constexpr bool PERM = true, AFTER_DRAIN = false; static DI bool keep_acc(const Unit&) { return false; }
    bf16* Z; bf16* KV;
    DI void operator()(f32x4 (&acc)[2][2][4][2], const Unit& u, int wr, int wc, int fr, int fq) const {
        bf16* base = u.w ? KV : Z; const int ld = u.w ? 2048 : ZLD;
        const int row0 = u.pm * BM + wr * 64 + fr, col0 = u.pn * BM + wc * 32 + 8 * fq;
        const bool ret = (u.w == 0) && (u.pn < 8);
        float lg2[2] = {0.f, 0.f};
        if (ret) {
#pragma unroll
            for (int bj = 0; bj < 2; ++bj) { const int hd = 2 * (u.pn & 3) + bj; lg2[bj] = log2f(1.f - exp2f(-5.f - (float)hd)) * (u.pn < 4 ? 1.f : -1.f); } }
#pragma unroll
        for (int ai = 0; ai < 2; ++ai)
#pragma unroll
            for (int m = 0; m < 4; ++m) { const int row = row0 + ai * HALF + m * 16; bf16* rowp = base + (size_t)row * ld + col0;
#pragma unroll
                for (int bj = 0; bj < 2; ++bj) { f32x4 v0 = acc[ai][bj][m][0], v1 = acc[ai][bj][m][1];
                    if (ret) { const float sc = __builtin_amdgcn_exp2f((float)(row & (SEQ - 1)) * lg2[bj]); v0 = v0 * sc; v1 = v1 * sc; }
                    u32x4 w; w.x = cvt_pk_bf16(v0[0], v0[1]); w.y = cvt_pk_bf16(v0[2], v0[3]); w.z = cvt_pk_bf16(v1[0], v1[1]); w.w = cvt_pk_bf16(v1[2], v1[3]);
                    *(u32x4*)(rowp + bj * HALF) = w; } }
    }
};
DI float expneg_c(float g) { return __expf(-fminf(fmaxf(g, -60.f), 60.f)); }
struct EpiGate {
    static constexpr bool PERM = true, AFTER_DRAIN = false; static DI bool keep_acc(const Unit& u) { return u.w < 2; }
    const bf16* Z; bf16* Out;
    DI void operator()(f32x4 (&acc)[2][2][4][2], const Unit& u, int wr, int wc, int fr, int fq) const {
        const int b = u.w;
        const int row0 = u.pm * BM + wr * 64 + fr, col0 = u.pn * BM + wc * 32 + 8 * fq;
        const bf16* ga = Z + ZC_GR + 2048 * b; const bf16* gb = ga + 2048;
#pragma unroll
        for (int ai = 0; ai < 2; ++ai)
#pragma unroll
            for (int m = 0; m < 4; ++m) { const size_t roff = (size_t)(row0 + ai * HALF + m * 16);
#pragma unroll
                for (int bj = 0; bj < 2; ++bj) { const int col = col0 + bj * HALF;
                    const u32x4 a = *(const u32x4*)(ga + roff * ZLD + col);
                    float ea[8] = {expneg_c(bflo(a.x)), expneg_c(bfhi(a.x)), expneg_c(bflo(a.y)), expneg_c(bfhi(a.y)), expneg_c(bflo(a.z)), expneg_c(bfhi(a.z)), expneg_c(bflo(a.w)), expneg_c(bfhi(a.w))};
                    float f[8];
                    if (b < 2) { const u32x4 c = *(const u32x4*)(gb + roff * ZLD + col);
                        const float eb[8] = {expneg_c(bflo(c.x)), expneg_c(bfhi(c.x)), expneg_c(bflo(c.y)), expneg_c(bfhi(c.y)), expneg_c(bflo(c.z)), expneg_c(bfhi(c.z)), expneg_c(bflo(c.w)), expneg_c(bfhi(c.w))};
#pragma unroll
                        for (int e = 0; e < 8; ++e) f[e] = (1.f + eb[e]) * __builtin_amdgcn_rcpf(1.f + ea[e]);
                    } else {
#pragma unroll
                        for (int e = 0; e < 8; ++e) f[e] = __builtin_amdgcn_rcpf(1.f + ea[e]);
                    }
                    f32x4 v0 = acc[ai][bj][m][0], v1 = acc[ai][bj][m][1];
                    v0[0] *= f[0]; v0[1] *= f[1]; v0[2] *= f[2]; v0[3] *= f[3]; v1[0] *= f[4]; v1[1] *= f[5]; v1[2] *= f[6]; v1[3] *= f[7];
                    if (b < 2) { acc[ai][bj][m][0] = v0; acc[ai][bj][m][1] = v1; }
                    else { u32x4 w; w.x = cvt_pk_bf16(v0[0], v0[1]); w.y = cvt_pk_bf16(v0[2], v0[3]); w.z = cvt_pk_bf16(v1[0], v1[1]); w.w = cvt_pk_bf16(v1[2], v1[3]);
                        *(u32x4*)(Out + roff * DM + col) = w; } } }
    }
};
struct EpiOutF32 {
    static constexpr bool PERM = true, AFTER_DRAIN = false; static DI bool keep_acc(const Unit&) { return false; }
    float* O;
    DI void operator()(f32x4 (&acc)[2][2][4][2], const Unit& u, int wr, int wc, int fr, int fq) const {
        const int row0 = u.pm * BM + wr * 64 + fr, col0 = u.pn * BM + wc * 32 + 8 * fq;
#pragma unroll
        for (int ai = 0; ai < 2; ++ai)
#pragma unroll
            for (int m = 0; m < 4; ++m) { float* rowp = O + (size_t)(row0 + ai * HALF + m * 16) * DM + col0;
#pragma unroll
                for (int bj = 0; bj < 2; ++bj) { *(f32x4*)(rowp + bj * HALF) = acc[ai][bj][m][0]; *(f32x4*)(rowp + bj * HALF + 4) = acc[ai][bj][m][1]; } }
    }
};
struct SchedP1 {
    int G, c; const char *A0, *B0, *A1, *B1;
    static constexpr int nM = MTOK / BM, nN = ZLD / BM, nwg = nM * nN, NKV = (MROWS / BM) * (2048 / BM);
    DI bool next(int i, Unit& u) const {
        const long L = (long)i * G + c; if (L >= nwg + NKV) return false;
        const int k = (int)L - nwg; const bool kv = k >= 0;
        int wgid = kv ? 0 : (int)L; { const int q = nwg / NXCD, r = nwg % NXCD, xcd = wgid % NXCD, off = wgid / NXCD; wgid = (xcd < r ? xcd * (q + 1) : r * (q + 1) + (xcd - r) * q) + off; }
        const int nig = WGM * nN, gid = wgid / nig, fm = gid * WGM, gsz = (nM - fm) < WGM ? (nM - fm) : WGM;
        const int pm0 = fm + ((wgid % nig) % gsz), pn0 = (wgid % nig) / gsz;
        Unit r_; r_.pm = kv ? (k & 3) : pm0; r_.pn = kv ? (k >> 2) : pn0; r_.w = kv ? 1 : 0; u = r_; return true;
    }
    DI const char* a_ptr(const Unit& u) const { return (u.w ? A1 : A0) + (size_t)u.pm * ((size_t)BM * DM * 2); }
    DI const char* b_ptr(const Unit& u) const { return (u.w ? B1 : B0) + (size_t)u.pn * ((size_t)BM * DM * 2); }
    DI void a_ready(const Unit&) const {}
    DI void done(const Unit&) const {}
};
struct SchedTile {
    int G, c, nb; const char *A, *B; size_t sAb, sBb; int lda, ldb;
    DI bool next(int i, Unit& u) const {
        const int T = (i / nb) * G + c; if (T >= 256) return false;
        const int xcd = T & 7, j = T >> 3; Unit r_; r_.w = i % nb; r_.pm = xcd * 4 + (j & 3); r_.pn = j >> 2; u = r_; return true;
    }
    DI const char* a_ptr(const Unit& u) const { return A + (size_t)u.w * sAb + (size_t)u.pm * ((size_t)BM * lda * 2); }
    DI const char* b_ptr(const Unit& u) const { return B + (size_t)u.w * sBb + (size_t)u.pn * ((size_t)BM * ldb * 2); }
    DI void a_ready(const Unit&) const {}
    DI void done(const Unit&) const {}
};
}

template <class Epi> DI void simple_gemm(Frame& F, const bf16* A, int lda, const bf16* Bt, int ldb, int M, int N, int K, const Epi& E) {
    const int wr = F.wave >> 2, wc = F.wave & 3, fr = F.lane & 15, fq = F.lane >> 4;
    const int ntn = N / 128, ntiles = (M / 128) * ntn;
    for (int t = blockIdx.x; t < ntiles; t += F.G) {
        const int tm = t / ntn, tn = t % ntn;
        const int row0 = tm * 128 + wr * 64, col0 = tn * 128 + wc * 32;
        f32x4 acc[4][2];
#pragma unroll
        for (int m = 0; m < 4; ++m)
#pragma unroll
            for (int n = 0; n < 2; ++n) acc[m][n] = (f32x4){0.f, 0.f, 0.f, 0.f};
        const bf16* ap = A + (size_t)(row0 + fr) * lda + 8 * fq;
        const bf16* bp = Bt + (size_t)(col0 + fr) * ldb + 8 * fq;
        for (int k0 = 0; k0 < K; k0 += 32) {
            bf16x8 a[4], b[2];
#pragma unroll
            for (int m = 0; m < 4; ++m) a[m] = *(const bf16x8*)(ap + (size_t)(16 * m) * lda + k0);
#pragma unroll
            for (int n = 0; n < 2; ++n) b[n] = *(const bf16x8*)(bp + (size_t)(16 * n) * ldb + k0);
#pragma unroll
            for (int m = 0; m < 4; ++m)
#pragma unroll
                for (int n = 0; n < 2; ++n) acc[m][n] = __builtin_amdgcn_mfma_f32_16x16x32_bf16(b[n], a[m], acc[m][n], 0, 0, 0);
        }
#pragma unroll
        for (int m = 0; m < 4; ++m)
#pragma unroll
            for (int n = 0; n < 2; ++n) E(row0 + 16 * m + fr, col0 + 16 * n + 4 * fq, acc[m][n]);
    }
}
struct EpiBf16Store { bf16* O; int ld;
    DI void operator()(int row, int col, f32x4 v) const { u32x2 o; o.x = pk2(v.x, v.y); o.y = pk2(v.z, v.w); *(u32x2*)(O + (size_t)row * ld + col) = o; } };
template <int MODE> struct EpiGate { const bf16* G; float* Mrg; bf16* Out;
    DI void operator()(int row, int col, f32x4 v) const {
        const u32x2 g = *(const u32x2*)(G + (size_t)row * ZLD + col);
        f32x4 r; r.x = sigmoid_f(bflo(g.x)) * v.x; r.y = sigmoid_f(bfhi(g.x)) * v.y; r.z = sigmoid_f(bflo(g.y)) * v.z; r.w = sigmoid_f(bfhi(g.y)) * v.w;
        float* mp = Mrg + (size_t)row * DM + col;
        if (MODE >= 1) r = r + *(const f32x4*)mp;
        if (MODE <= 1) *(f32x4*)mp = r;
        else { u32x2 o; o.x = pk2(r.x, r.y); o.y = pk2(r.z, r.w); *(u32x2*)(Out + (size_t)row * DM + col) = o; }
    } };
struct EpiF32Store { float* O; int ld;
    DI void operator()(int row, int col, f32x4 v) const { *(f32x4*)(O + (size_t)row * ld + col) = v; } };

DI unsigned okey(float f) { const unsigned u = __builtin_bit_cast(unsigned, f); return (u & 0x80000000u) ? ~u : (u | 0x80000000u); }

DI void p_indexer_naive(Frame& F) {
    LAS float* qf = (LAS float*)F.lds;
    LAS float* wf = qf + 1024;
    LAS float* sc = qf + 1024 + 64;
    LAS int* red = (LAS int*)(sc + 2048);
    const int tid = F.tid;
    for (int t = blockIdx.x; t < MTOK; t += F.G) {
        const int b = t / SEQ, i = t % SEQ;
        const bf16* zrow = F.Z + (size_t)t * ZLD;
        for (int e = tid; e < 1024; e += NTHR) qf[e] = bf2f(zrow[ZC_IQ + e]);
        if (tid < 16) wf[tid] = bf2f(zrow[ZC_IW + tid]);
        __syncthreads();
        for (int s = tid; s <= i; s += NTHR) {
            const u32x4* kp = (const u32x4*)(F.Z + (size_t)(b * SEQ + s) * ZLD + ZC_IK);
            float kf[64];
#pragma unroll
            for (int c = 0; c < 8; ++c) { const u32x4 w = kp[c];
                kf[8 * c + 0] = bflo(w.x); kf[8 * c + 1] = bfhi(w.x); kf[8 * c + 2] = bflo(w.y); kf[8 * c + 3] = bfhi(w.y);
                kf[8 * c + 4] = bflo(w.z); kf[8 * c + 5] = bfhi(w.z); kf[8 * c + 6] = bflo(w.w); kf[8 * c + 7] = bfhi(w.w); }
            float score = 0.f;
            for (int h = 0; h < 16; ++h) { float d = 0.f;
#pragma unroll
                for (int e = 0; e < 64; ++e) d += qf[h * 64 + e] * kf[e];
                score += wf[h] * fmaxf(d, 0.f); }
            sc[s] = score;
        }
        __syncthreads();
        const int n = i + 1;
        unsigned T = 0u;
        if (n > TOPK) {
            for (int bit = 31; bit >= 0; --bit) {
                const unsigned cand = T | (1u << bit);
                int cnt = 0;
                for (int s = tid; s <= i; s += NTHR) cnt += (okey(sc[s]) >= cand) ? 1 : 0;
                cnt = wave_sum_i(cnt);
                if (F.lane == 0) red[F.wave] = cnt;
                __syncthreads();
                int tot = 0;
#pragma unroll
                for (int w = 0; w < 8; ++w) tot += red[w];
                __syncthreads();
                if (tot >= TOPK) T = cand;
            }
        }
        if (tid < 64) { unsigned w = 0u;
            for (int j = 0; j < 32; ++j) { const int s = 32 * tid + j; if (s <= i && (n <= TOPK || okey(sc[s]) >= T)) w |= (1u << j); }
            F.Mask[(size_t)t * 64 + tid] = w; }
        __syncthreads();
    }
}

DI void p_dsa_naive(Frame& F) {
    LAS int* sel = (LAS int*)F.lds;
    LAS int* cw = sel + 320;
    LAS float* lg = (LAS float*)(cw + 80);
    const int tid = F.tid, lane = F.lane, h = F.wave;
    bf16* Y = F.Yb + (size_t)MTOK * 1024;
    for (int t = blockIdx.x; t < MTOK; t += F.G) {
        const int b = t / SEQ, i = t % SEQ;
        unsigned mw = 0u;
        if (tid < 64) { mw = F.Mask[(size_t)t * 64 + tid]; cw[tid] = __popc(mw); }
        __syncthreads();
        if (tid == 0) { int run = 0; for (int k = 0; k < 64; ++k) { const int c = cw[k]; cw[k] = run; run += c; } cw[64] = run; }
        __syncthreads();
        if (tid < 64) { int o = cw[tid]; unsigned w = mw; while (w) { const int j = __ffs(w) - 1; w &= w - 1u; if (o < 320) sel[o] = 32 * tid + j; ++o; } }
        __syncthreads();
        const int nsel = cw[64] < 320 ? cw[64] : 320;
        const bf16* zrow = F.Z + (size_t)t * ZLD;
        const unsigned qw = *(const unsigned*)(zrow + ZC_AQ + h * 128 + 2 * lane);
        const float q0 = bflo(qw), q1 = bfhi(qw);
        const float slope = exp2f(-(float)(h + 1));
        float mx = -1e30f;
        for (int idx = 0; idx < nsel; ++idx) {
            const int j = sel[idx];
            const unsigned kw = *(const unsigned*)(F.Z + (size_t)(b * SEQ + j) * ZLD + ZC_AK + h * 128 + 2 * lane);
            const float d = wave_sum(q0 * bflo(kw) + q1 * bfhi(kw));
            const float l = d - slope * (float)(i - j);
            if (lane == 0) lg[h * 320 + idx] = l;
            mx = fmaxf(mx, l);
        }
        float sum = 0.f;
        for (int idx = lane; idx < nsel; idx += 64) sum += __expf(lg[h * 320 + idx] - mx);
        sum = wave_sum(sum);
        const float inv = 1.f / sum;
        float a0 = 0.f, a1 = 0.f;
        for (int idx = 0; idx < nsel; ++idx) {
            const int j = sel[idx];
            const float p = __expf(lg[h * 320 + idx] - mx) * inv;
            const unsigned vw = *(const unsigned*)(F.Z + (size_t)(b * SEQ + j) * ZLD + ZC_AV + h * 128 + 2 * lane);
            a0 += p * bflo(vw); a1 += p * bfhi(vw);
        }
        const unsigned gw = *(const unsigned*)(zrow + ZC_AG + h * 128 + 2 * lane);
        *(unsigned*)(Y + (size_t)t * 1024 + h * 128 + 2 * lane) = pk2(silu_f(bflo(gw)) * a0, silu_f(bfhi(gw)) * a1);
        __syncthreads();
    }
}

DI void p_ret_naive(Frame& F) {
    const int lane = F.lane, h = F.wave;
    const float log_g = log1pf(-exp2f(-5.f - (float)h));
    for (int t = blockIdx.x; t < MTOK; t += F.G) {
        const int b = t / SEQ, i = t % SEQ;
        const bf16* zrow = F.Z + (size_t)t * ZLD;
        const unsigned qw = *(const unsigned*)(zrow + ZC_RQ + h * 128 + 2 * lane);
        const float q0 = bflo(qw), q1 = bfhi(qw);
        float a0 = 0.f, a1 = 0.f;
        for (int j = 0; j <= i; ++j) {
            const bf16* kr = F.Z + (size_t)(b * SEQ + j) * ZLD;
            const unsigned kw = *(const unsigned*)(kr + ZC_RK + h * 128 + 2 * lane);
            const unsigned vw = *(const unsigned*)(kr + ZC_RV + h * 128 + 2 * lane);
            const float d = wave_sum(q0 * bflo(kw) + q1 * bfhi(kw)) * __expf(log_g * (float)(i - j));
            a0 += d * bflo(vw); a1 += d * bfhi(vw);
        }
        const float mean = wave_sum(a0 + a1) * (1.f / 128.f);
        const float d0 = a0 - mean, d1 = a1 - mean;
        const float var = wave_sum(d0 * d0 + d1 * d1) * (1.f / 128.f);
        const float rs = 1.0f / sqrtf(var + 1e-5f);
        const float w0 = F.gn_w[h * 128 + 2 * lane], w1 = F.gn_w[h * 128 + 2 * lane + 1];
        const unsigned gw = *(const unsigned*)(zrow + ZC_RG + h * 128 + 2 * lane);
        *(unsigned*)(F.Yb + (size_t)t * 1024 + h * 128 + 2 * lane) = pk2(silu_f(bflo(gw)) * d0 * rs * w0, silu_f(bfhi(gw)) * d1 * rs * w1);
    }
}

DI void p_mem_naive(Frame& F) {
    LAS float* lg = (LAS float*)F.lds;
    const int lane = F.lane, w = F.wave, hh = w & 3;
    bf16* Y = F.Yb + (size_t)2 * MTOK * 1024;
    for (int t2 = blockIdx.x; t2 < MTOK / 2; t2 += F.G) {
        const int t = 2 * t2 + (w >> 2), b = t / SEQ;
        const bf16* zrow = F.Z + (size_t)t * ZLD;
        const u32x2 qw = *(const u32x2*)(zrow + ZC_MQ + hh * 256 + 4 * lane);
        const float q0 = bflo(qw.x), q1 = bfhi(qw.x), q2 = bflo(qw.y), q3 = bfhi(qw.y);
        float mx = -1e30f;
        for (int m = 0; m < MEMT; ++m) {
            const u32x2 kw = *(const u32x2*)(F.KVm + (size_t)(b * MEMT + m) * 2048 + hh * 256 + 4 * lane);
            const float d = wave_sum(q0 * bflo(kw.x) + q1 * bfhi(kw.x) + q2 * bflo(kw.y) + q3 * bfhi(kw.y));
            if (lane == 0) lg[w * 256 + m] = d;
            mx = fmaxf(mx, d);
        }
        float sum = 0.f;
        for (int m = lane; m < MEMT; m += 64) sum += __expf(lg[w * 256 + m] - mx);
        sum = wave_sum(sum);
        const float inv = 1.f / sum;
        float a0 = 0.f, a1 = 0.f, a2 = 0.f, a3 = 0.f;
        for (int m = 0; m < MEMT; ++m) {
            const float p = __expf(lg[w * 256 + m] - mx) * inv;
            const u32x2 vw = *(const u32x2*)(F.KVm + (size_t)(b * MEMT + m) * 2048 + 1024 + hh * 256 + 4 * lane);
            a0 += p * bflo(vw.x); a1 += p * bfhi(vw.x); a2 += p * bflo(vw.y); a3 += p * bfhi(vw.y);
        }
        const u32x2 gw = *(const u32x2*)(zrow + ZC_MG + hh * 256 + 4 * lane);
        u32x2 o; o.x = pk2(silu_f(bflo(gw.x)) * a0, silu_f(bfhi(gw.x)) * a1); o.y = pk2(silu_f(bflo(gw.y)) * a2, silu_f(bfhi(gw.y)) * a3);
        *(u32x2*)(Y + (size_t)t * 1024 + hh * 256 + 4 * lane) = o;
    }
}

DI void p_final(Frame& F) {
    const int gw = blockIdx.x * NWAVES + F.wave, NGW = F.G * NWAVES, lane = F.lane;
    for (int m = gw; m < MTOK; m += NGW) {
        f32x4* orow = (f32x4*)(F.out + (size_t)m * DM) + lane; const f32x4* xr = (const f32x4*)(F.x + (size_t)m * DM) + lane; const f32x4* wr = (const f32x4*)F.post_w + lane;
        f32x4 v[8]; float s = 0.f;
#pragma unroll
        for (int j = 0; j < 8; ++j) { v[j] = orow[64 * j]; s += (v[j].x * v[j].x + v[j].y * v[j].y) + (v[j].z * v[j].z + v[j].w * v[j].w); }
        const float r = 1.0f / sqrtf(wave_sum(s) * (1.f / DM) + 1e-6f);
#pragma unroll
        for (int j = 0; j < 8; ++j) orow[64 * j] = xr[64 * j] + v[j] * r * wr[64 * j];
    }
}


namespace att {
typedef float f32x16 __attribute__((ext_vector_type(16)));
typedef short v4i16_t __attribute__((ext_vector_type(4)));
typedef __bf16 bf16x2_t __attribute__((ext_vector_type(2)));
typedef float f32x2_t __attribute__((ext_vector_type(2)));
constexpr float LOG2E = 1.4426950408889634f;
DI unsigned off_b(unsigned row, unsigned ch) { return 256u * row + 16u * (ch ^ (((row & 3) << 2) | ((row >> 2) & 3))); }
DI f32x16 mfma32(bf16x8 a, bf16x8 b, f32x16 c) { return __builtin_amdgcn_mfma_f32_32x32x16_bf16(a, b, c, 0, 0, 0); }
DI unsigned cvtpk(float lo, float hi) { f32x2_t v = {lo, hi}; bf16x2_t o = __builtin_convertvector(v, bf16x2_t); return __builtin_bit_cast(unsigned, o); }
DI v4i16_t vtr(unsigned addr) { return __builtin_amdgcn_ds_read_tr16_b64_v4i16((LAS v4i16_t*)(uintptr_t)addr); }
DI bf16x8 pack8(const f32x16& x, int s) { u32x4 p; p.x = cvtpk(x[8 * s + 0], x[8 * s + 1]); p.y = cvtpk(x[8 * s + 2], x[8 * s + 3]); p.z = cvtpk(x[8 * s + 4], x[8 * s + 5]); p.w = cvtpk(x[8 * s + 6], x[8 * s + 7]); return __builtin_bit_cast(bf16x8, p); }

template <int MODE> DI void attn_unit(Frame& F, int b, int h, int qb) {
    const int tid = F.tid, lane = F.lane, w = F.wave, r = lane & 31, hh = lane >> 5;
    const int q0 = qb * 256, qrow = q0 + 32 * w + r, qt = 8 * qb + w;
    constexpr int zq = MODE ? ZC_AQ : ZC_RQ, zk = MODE ? ZC_AK : ZC_RK, zv = MODE ? ZC_AV : ZC_RV, zg = MODE ? ZC_AG : ZC_RG;
    const bf16* Zb = F.Z + (size_t)b * SEQ * ZLD;
    const unsigned ldsb = (unsigned)(uintptr_t)F.lds;
    bf16x8 qf[8];
    { const bf16* qp = Zb + (size_t)qrow * ZLD + zq + h * 128 + 8 * hh;
#pragma unroll
      for (int ks = 0; ks < 8; ++ks) qf[ks] = *(const bf16x8*)(qp + 16 * ks); }
    const int srow = tid >> 4, sch = tid & 15;
    const bf16* kg = Zb + (size_t)srow * ZLD + zk + h * 128 + sch * 8;
    const bf16* vg = Zb + (size_t)srow * ZLD + zv + h * 128 + sch * 8;
    const unsigned lo0 = off_b(srow, sch), lo1 = off_b(srow + 32, sch);
    unsigned kaddr[8], vaddr[4][2];
#pragma unroll
    for (int ks = 0; ks < 8; ++ks) kaddr[ks] = off_b(r, 2 * ks + hh);
    { const unsigned blk = (lane >> 4) & 1, q = (lane & 15) >> 2, p = lane & 3;
#pragma unroll
      for (int c = 0; c < 4; ++c)
#pragma unroll
        for (int t = 0; t < 2; ++t) vaddr[c][t] = off_b(8 * t + 4 * hh + q, 4 * c + 2 * blk + (p >> 1)) + 8 * (p & 1); }
    const unsigned* mrow = F.Mask + (size_t)(b * SEQ + qrow) * 64;
    const float slope2 = exp2f(-(float)(h + 1)) * LOG2E;
    f32x16 o[4];
#pragma unroll
    for (int c = 0; c < 4; ++c)
#pragma unroll
        for (int i = 0; i < 16; ++i) o[c][i] = 0.f;
    float m = -1e30f, l = 0.f;
    const int nst = 4 * (qb + 1);
    u32x4 kr0, kr1, vr0, vr1; u32x2 mw = {0u, 0u}, mwn = {0u, 0u};
    kr0 = *(const u32x4*)kg; kr1 = *(const u32x4*)(kg + (size_t)32 * ZLD); vr0 = *(const u32x4*)vg; vr1 = *(const u32x4*)(vg + (size_t)32 * ZLD);
    if (MODE) mw = *(const u32x2*)mrow;
    *(LAS u32x4*)(F.lds + lo0) = kr0; *(LAS u32x4*)(F.lds + lo1) = kr1; *(LAS u32x4*)(F.lds + 32768 + lo0) = vr0; *(LAS u32x4*)(F.lds + 32768 + lo1) = vr1;
    __syncthreads();
    for (int st = 0; st < nst; ++st) {
        const int cur = st & 1; const bool more = (st + 1 < nst);
        if (more) { const size_t go = (size_t)(64 * (st + 1)) * ZLD;
            kr0 = *(const u32x4*)(kg + go); kr1 = *(const u32x4*)(kg + go + (size_t)32 * ZLD); vr0 = *(const u32x4*)(vg + go); vr1 = *(const u32x4*)(vg + go + (size_t)32 * ZLD);
            if (MODE) mwn = *(const u32x2*)(mrow + 2 * (st + 1)); }
        const unsigned kb = ldsb + cur * 16384, vb = ldsb + 32768 + cur * 16384;
#pragma unroll
        for (int tt = 0; tt < 2; ++tt) {
            const int kt = 2 * st + tt;
            if (kt <= qt) {
                f32x16 s;
#pragma unroll
                for (int i = 0; i < 16; ++i) s[i] = 0.f;
#pragma unroll
                for (int ks = 0; ks < 8; ++ks) { const bf16x8 kf = *(const LAS bf16x8*)(uintptr_t)(kb + tt * 8192 + kaddr[ks]); s = mfma32(kf, qf[ks], s); }
                if (MODE) {
                    const unsigned mv = (tt ? mw.y : mw.x) >> (4 * hh);
                    const float tb = slope2 * (float)(32 * kt + 4 * hh - qrow);
                    float mt = -1e30f;
#pragma unroll
                    for (int i = 0; i < 16; ++i) { const int ci = (i & 3) + 8 * (i >> 2);
                        float lg = __builtin_fmaf(slope2, (float)ci, __builtin_fmaf(s[i], LOG2E, tb));
                        lg = ((mv >> ci) & 1u) ? lg : -1e30f; s[i] = lg; mt = fmaxf(mt, lg); }
                    mt = fmaxf(mt, __shfl_xor(mt, 32));
                    const float mn = fmaxf(m, mt), alpha = __builtin_amdgcn_exp2f(m - mn); m = mn;
                    float ps = 0.f;
#pragma unroll
                    for (int i = 0; i < 16; ++i) { const float p = __builtin_amdgcn_exp2f(s[i] - mn); s[i] = p; ps += p; }
                    l = l * alpha + ps;
                    if (__any(alpha != 1.f)) {
#pragma unroll
                        for (int c = 0; c < 4; ++c)
#pragma unroll
                            for (int i = 0; i < 16; ++i) o[c][i] *= alpha; }
                } else {
                    if (kt == qt) {
#pragma unroll
                        for (int i = 0; i < 16; ++i) { const int ci = (i & 3) + 8 * (i >> 2); s[i] = (ci + 4 * hh <= r) ? s[i] : 0.f; } }
                }
                const bf16x8 pf0 = pack8(s, 0), pf1 = pack8(s, 1);
#pragma unroll
                for (int c = 0; c < 4; ++c) {
                    const unsigned va = vb + tt * 8192;
                    const v4i16_t a00 = vtr(va + vaddr[c][0]), a01 = vtr(va + vaddr[c][1]), a10 = vtr(va + 4096 + vaddr[c][0]), a11 = vtr(va + 4096 + vaddr[c][1]);
                    const bf16x8 A0 = {a00[0], a00[1], a00[2], a00[3], a01[0], a01[1], a01[2], a01[3]};
                    const bf16x8 A1 = {a10[0], a10[1], a10[2], a10[3], a11[0], a11[1], a11[2], a11[3]};
                    o[c] = mfma32(A0, pf0, o[c]); o[c] = mfma32(A1, pf1, o[c]);
                }
            }
        }
        if (more) { const unsigned nb = (cur ^ 1) * 16384;
            *(LAS u32x4*)(F.lds + nb + lo0) = kr0; *(LAS u32x4*)(F.lds + nb + lo1) = kr1; *(LAS u32x4*)(F.lds + 32768 + nb + lo0) = vr0; *(LAS u32x4*)(F.lds + 32768 + nb + lo1) = vr1;
            if (MODE) mw = mwn; }
        __syncthreads();
    }
    const bf16* grow = Zb + (size_t)qrow * ZLD + zg + h * 128 + 4 * hh;
    bf16* yrow = F.Yb + (size_t)(MODE ? MTOK : 0) * 1024 + (size_t)(b * SEQ + qrow) * 1024 + h * 128 + 4 * hh;
    if (MODE) {
        const float lt = l + __shfl_xor(l, 32), inv = 1.f / lt;
#pragma unroll
        for (int c = 0; c < 4; ++c)
#pragma unroll
            for (int g = 0; g < 4; ++g) { const int d0 = 32 * c + 8 * g; const u32x2 gw = *(const u32x2*)(grow + d0);
                u32x2 ov; ov.x = pk2(silu_f(bflo(gw.x)) * o[c][4 * g + 0] * inv, silu_f(bfhi(gw.x)) * o[c][4 * g + 1] * inv);
                ov.y = pk2(silu_f(bflo(gw.y)) * o[c][4 * g + 2] * inv, silu_f(bfhi(gw.y)) * o[c][4 * g + 3] * inv);
                *(u32x2*)(yrow + d0) = ov; }
    } else {
        float sm = 0.f;
#pragma unroll
        for (int c = 0; c < 4; ++c)
#pragma unroll
            for (int i = 0; i < 16; ++i) sm += o[c][i];
        sm += __shfl_xor(sm, 32);
        const float mean = sm * (1.f / 128.f);
        float sv = 0.f;
#pragma unroll
        for (int c = 0; c < 4; ++c)
#pragma unroll
            for (int i = 0; i < 16; ++i) { const float d = o[c][i] - mean; sv += d * d; }
        sv += __shfl_xor(sv, 32);
        const float rs = 1.0f / sqrtf(sv * (1.f / 128.f) + 1e-5f);
        const float* gnw = F.gn_w + h * 128 + 4 * hh;
#pragma unroll
        for (int c = 0; c < 4; ++c)
#pragma unroll
            for (int g = 0; g < 4; ++g) { const int d0 = 32 * c + 8 * g; const u32x2 gw = *(const u32x2*)(grow + d0); const f32x4 wv = *(const f32x4*)(gnw + d0);
                u32x2 ov; ov.x = pk2(silu_f(bflo(gw.x)) * (o[c][4 * g + 0] - mean) * rs * wv.x, silu_f(bfhi(gw.x)) * (o[c][4 * g + 1] - mean) * rs * wv.y);
                ov.y = pk2(silu_f(bflo(gw.y)) * (o[c][4 * g + 2] - mean) * rs * wv.z, silu_f(bfhi(gw.y)) * (o[c][4 * g + 3] - mean) * rs * wv.w);
                *(u32x2*)(yrow + d0) = ov; }
    }
}
DI void p_attn(Frame& F) {
    for (int it = blockIdx.x; it < 256; it += F.G) {
        const int xcd = it & 7, j = it >> 3, bh = xcd * 4 + (j >> 3), qb = j & 7, b = bh >> 3, h = bh & 7;
        attn_unit<1>(F, b, h, qb);
        attn_unit<0>(F, b, h, 7 - qb);
    }
}
}

constexpr int N_PHASES = 9;
struct Args { const float* in[12]; float* out; unsigned char* ws; int ph_lo, ph_hi; };
__global__ void __launch_bounds__(NTHR, 2) layer_fwd(Args args) {
    extern __shared__ __attribute__((aligned(16))) unsigned char lds[];
    Frame F;
    F.lds = (LAS unsigned char*)lds;
    F.tid = threadIdx.x; F.lane = F.tid & 63; F.wave = __builtin_amdgcn_readfirstlane(F.tid >> 6); F.G = gridDim.x;
    unsigned char* ws = args.ws;
    F.x = args.in[0]; F.mem = args.in[1]; F.pre_w = args.in[2]; F.w_in = args.in[3]; F.gn_w = args.in[4]; F.memn_w = args.in[5]; F.w_kv = args.in[6];
    F.w_up[0] = args.in[7]; F.w_up[1] = args.in[8]; F.w_up[2] = args.in[9]; F.w_o = args.in[10]; F.post_w = args.in[11]; F.out = args.out;
    F.WinT = (bf16*)(ws + WS_WINT); F.WkvT = (bf16*)(ws + WS_WKVT); F.WupT = (bf16*)(ws + WS_WUPT); F.WoT = (bf16*)(ws + WS_WOT);
    F.Hb = (bf16*)(ws + WS_HB); F.MemN = (bf16*)(ws + WS_MEMN); F.KVm = (bf16*)(ws + WS_KVM); F.Yb = (bf16*)(ws + WS_YB); F.Z = (bf16*)(ws + WS_Z);
    F.Merged = (bf16*)(ws + WS_MERGED); F.Mrg = (float*)(ws + WS_MRG); F.Mask = (unsigned*)(ws + WS_MASK);
    volatile LAS unsigned* MISC = (volatile LAS unsigned*)(F.lds + MISC_OFF);
    if (F.tid < 32) MISC[F.tid] = 0u;
    __syncthreads();
    const int lo = args.ph_lo, hi = args.ph_hi;
    const bool one = (hi - lo) > 1;
    XcdBarrier bar; bar.bar = (unsigned*)(ws + WS_CTL) + CW_BAR; bar.x = 0; bar.st = nullptr;
    if (one) bar = xcd_barrier_post((unsigned*)(ws + WS_CTL) + CW_BAR, MISC + 8);
#define IN(k) (lo <= (k) && (k) < hi)
#define SEAM(k) do { if (IN(k) && IN((k) + 1)) xcd_barrier(bar); } while (0)
    if (IN(0)) { p0_prologue(F); } SEAM(0);
    if (IN(1)) {
        pg8::GemmG g{DM, DM, DM}; pg8::SchedP1 S{F.G, (int)blockIdx.x, (const char*)F.Hb, (const char*)F.WinT, (const char*)F.MemN, (const char*)F.WkvT};
        pg8::EpiZ E{F.Z, F.KVm};
        pg8::gemm_phase<pg8::EpiZ, pg8::SchedP1, true, true>(F.lds, g, S, E);
    } SEAM(1);
    if (IN(2)) { p_indexer_naive(F); } SEAM(2);
    if (IN(3)) { att::p_attn(F); } SEAM(3);
    if (IN(4)) { } SEAM(4);
    if (IN(5)) { p_mem_naive(F); } SEAM(5);
    if (IN(6)) {
        pg8::GemmG g{1024, 1024, 1024}; pg8::SchedTile S{F.G, (int)blockIdx.x, 3, (const char*)F.Yb, (const char*)F.WupT, (size_t)MTOK * 1024 * 2, (size_t)DM * 1024 * 2, 1024, 1024};
        pg8::EpiGate E{F.Z, F.Merged};
        pg8::gemm_phase<pg8::EpiGate, pg8::SchedTile, true, true>(F.lds, g, S, E);
    } SEAM(6);
    if (IN(7)) {
        pg8::GemmG g{DM, DM, DM}; pg8::SchedTile S{F.G, (int)blockIdx.x, 1, (const char*)F.Merged, (const char*)F.WoT, 0, 0, DM, DM};
        pg8::EpiOutF32 E{F.out};
        pg8::gemm_phase<pg8::EpiOutF32, pg8::SchedTile, true, true>(F.lds, g, S, E);
    } SEAM(7);
    if (IN(8)) { p_final(F); }
#undef IN
#undef SEAM
}

extern "C" void kernel_launch(void* const* d_in, const int* in_sizes, int n_in, void* d_out, int out_size, void* d_ws, size_t ws_size, hipStream_t stream) {
    static int grid = 0;
    if (grid == 0) {
        if (n_in != 12 || out_size != MTOK * DM || ws_size < WS_END) { fprintf(stderr, "kernel_launch: unexpected problem (n_in %d, out %d, ws %zu)\n", n_in, out_size, ws_size); grid = -1; return; }
        int dev = 0, cus = 0;
        if (hipGetDevice(&dev) != hipSuccess || hipDeviceGetAttribute(&cus, hipDeviceAttributeMultiprocessorCount, dev) != hipSuccess) { grid = -1; return; }
        if (hipFuncSetAttribute((const void*)layer_fwd, hipFuncAttributeMaxDynamicSharedMemorySize, LDS_BYTES) != hipSuccess) { fprintf(stderr, "kernel_launch: hipFuncSetAttribute failed\n"); grid = -1; return; }
        int per_cu = 0;
        if (hipOccupancyMaxActiveBlocksPerMultiprocessor(&per_cu, (const void*)layer_fwd, NTHR, LDS_BYTES) != hipSuccess || per_cu < 1) fprintf(stderr, "kernel_launch: occupancy query reports %d\n", per_cu);
        (void)hipGetLastError();
        grid = cus;
    }
    if (grid < 0) return;
    (void)hipMemsetAsync((char*)d_ws + WS_CTL, 0, CTL_ZERO_BYTES, stream);
    Args a{};
    for (int i = 0; i < 12; ++i) a.in[i] = (const float*)d_in[i];
    a.out = (float*)d_out; a.ws = (unsigned char*)d_ws;
#if MK_N_LAUNCHES == 1
    a.ph_lo = 0; a.ph_hi = N_PHASES;
    hipLaunchKernelGGL(layer_fwd, dim3(grid), dim3(NTHR), LDS_BYTES, stream, a);
#else
    for (int p = 0; p < N_PHASES; ++p) { a.ph_lo = p; a.ph_hi = p + 1; hipLaunchKernelGGL(layer_fwd, dim3(grid), dim3(NTHR), LDS_BYTES, stream, a); }
#endif
}
```

```cpp
#include <hip/hip_runtime.h>
#include <cstdio>
#include <cstdint>

#ifndef MK_N_LAUNCHES
#define MK_N_LAUNCHES 1
#endif

#define GAS __attribute__((address_space(1)))
#define LAS __attribute__((address_space(3)))
typedef unsigned short bf16;
typedef short bf16x8 __attribute__((ext_vector_type(8)));
typedef float f32x4 __attribute__((ext_vector_type(4)));
typedef unsigned u32x4 __attribute__((ext_vector_type(4)));
typedef unsigned u32x2 __attribute__((ext_vector_type(2)));
typedef GAS unsigned gu32;
#define RLX_AGENT __ATOMIC_RELAXED, __HIP_MEMORY_SCOPE_AGENT
#define DI __device__ __forceinline__

constexpr int NB = 4, SEQ = 2048, DM = 2048, MTOK = NB * SEQ;
constexpr int NIN = 17488, ZLD = 17664;
constexpr int MEMT = 256, MROWS = NB * MEMT;
constexpr int ZC_RQ = 0, ZC_RK = 1024, ZC_RV = 2048, ZC_RG = 3072, ZC_AQ = 4096, ZC_AK = 5120, ZC_AV = 6144, ZC_AG = 7168,
              ZC_IQ = 8192, ZC_IK = 9216, ZC_IW = 9280, ZC_PAD = 9296, ZC_MQ = 9472, ZC_MG = 10496, ZC_GR = 11520, ZC_GD = 13568, ZC_GM = 15616;
constexpr int TOPK = 256;

constexpr size_t MiB = 1u << 20;
constexpr size_t WS_CTL = 0, CTL_ZERO_BYTES = 1 * MiB;
constexpr size_t WS_WINT = 1 * MiB;
constexpr size_t WS_MRG = 1 * MiB;
constexpr size_t WS_WKVT = 70 * MiB;
constexpr size_t WS_WUPT = 78 * MiB;
constexpr size_t WS_WOT = 90 * MiB;
constexpr size_t WS_HB = 98 * MiB;
constexpr size_t WS_MERGED = 98 * MiB;
constexpr size_t WS_MEMN = 130 * MiB;
constexpr size_t WS_KVM = 134 * MiB;
constexpr size_t WS_MASK = 138 * MiB;
constexpr size_t WS_YB = 141 * MiB;
constexpr size_t WS_Z = 189 * MiB;
constexpr size_t WS_END = 465 * MiB;
static_assert(WS_WINT + (size_t)ZLD * DM * 2 <= WS_WKVT && WS_Z + (size_t)MTOK * ZLD * 2 <= WS_END, "ws map");

constexpr int CW_BAR = 4096;

constexpr int NWAVES = 8, NTHR = 512;
constexpr int LDS_BYTES = 147456;
constexpr int MISC_OFF = 139264;

DI unsigned f2bf(float f) { unsigned u = __builtin_bit_cast(unsigned, f); return (u + 0x7fffu + ((u >> 16) & 1u)) >> 16; }
DI unsigned pk2(float lo, float hi) { return f2bf(lo) | (f2bf(hi) << 16); }
DI float bf2f(unsigned h) { return __builtin_bit_cast(float, h << 16); }
DI float bflo(unsigned w) { return __builtin_bit_cast(float, w << 16); }
DI float bfhi(unsigned w) { return __builtin_bit_cast(float, w & 0xffff0000u); }
DI float wave_sum(float v) {
#pragma unroll
    for (int o = 1; o < 64; o <<= 1) v += __shfl_xor(v, o);
    return v;
}
DI int wave_sum_i(int v) {
#pragma unroll
    for (int o = 1; o < 64; o <<= 1) v += __shfl_xor(v, o);
    return v;
}
DI float wave_max(float v) {
#pragma unroll
    for (int o = 1; o < 64; o <<= 1) v = fmaxf(v, __shfl_xor(v, o));
    return v;
}
DI float silu_f(float x) { return x / (1.f + __expf(-x)); }
DI float sigmoid_f(float x) { return 1.f / (1.f + __expf(-x)); }

#define XB_TMO      128
#define XB_XCNT(j)  (256  + 64 * (j))
#define XB_XSUB(j)  (1280 + 64 * (j))
#define XB_XGEN(j)  (2304 + 64 * (j))
#define XB_TOP      3328
#define XB_TOPGEN   3392
#define XCD_BAR_WORDS 3456
#define XB_SPIN_CAP (1u << 22)
DI unsigned xb_ld(unsigned* p)              { return __hip_atomic_load(p, __ATOMIC_RELAXED, __HIP_MEMORY_SCOPE_AGENT); }
DI unsigned xb_add(unsigned* p, unsigned v) { return __hip_atomic_fetch_add(p, v, __ATOMIC_RELAXED, __HIP_MEMORY_SCOPE_AGENT); }
DI unsigned xb_xcc_id() { return (unsigned)__builtin_amdgcn_s_getreg((3 << 11) | 20) & 0xFu; }
#define XB_SPIN(cond, bar) do { unsigned _sp = 0; while (cond) { __builtin_amdgcn_s_sleep(1); \
    if ((++_sp & 255u) == 0u) { if (xb_ld(&(bar)[XB_TMO])) break; if (_sp > XB_SPIN_CAP) { atomicAdd(&(bar)[XB_TMO], 1u); break; } } } } while (0)
struct XcdBarrier { unsigned* bar; unsigned x; volatile LAS unsigned* st; };
DI XcdBarrier xcd_barrier_post(unsigned* bar, volatile LAS unsigned* st) {
    XcdBarrier b; b.bar = bar; b.x = xb_xcc_id(); b.st = st;
    if (threadIdx.x == 0) (void)xb_add(&bar[XB_XCNT(b.x)], 1u);
    return b;
}
DI void xcd_barrier_complete(unsigned* bar, unsigned x, unsigned& nloc, unsigned& nx) {
    const unsigned G = gridDim.x * gridDim.y * gridDim.z;
    unsigned sum, cnt, mine, sp = 0u;
    for (;;) {
        sum = 0u; cnt = 0u; mine = 0u;
#pragma unroll
        for (unsigned j = 0; j < 16; ++j) { const unsigned c = xb_ld(&bar[XB_XCNT(j)]); sum += c; cnt += (c > 0u) ? 1u : 0u; mine = (j == x) ? c : mine; }
        if (sum == G) break;
        __builtin_amdgcn_s_sleep(1);
        if ((++sp & 255u) == 0u) { if (xb_ld(&bar[XB_TMO])) break; if (sp > XB_SPIN_CAP) { atomicAdd(&bar[XB_TMO], 1u); break; } }
    }
    nloc = mine > 0u ? mine : 1u; nx = cnt > 0u ? cnt : 1u;
}
DI void xcd_barrier(const XcdBarrier& b) {
    asm volatile("s_waitcnt vmcnt(0)" ::: "memory");
    __syncthreads();
    if (threadIdx.x == 0) {
        unsigned* bar = b.bar;
        __builtin_amdgcn_s_waitcnt(0);
        unsigned nloc = b.st[0], nx = b.st[1];
        if (nloc == 0u) { xcd_barrier_complete(bar, b.x, nloc, nx); b.st[0] = nloc; b.st[1] = nx; }
        const unsigned old = xb_add(&bar[XB_XSUB(b.x)], 1u);
        const unsigned gen = old / nloc;
        if (old + 1u == (gen + 1u) * nloc) {
            __builtin_amdgcn_fence(__ATOMIC_RELEASE, "agent");
            asm volatile("s_waitcnt vmcnt(0)" ::: "memory");
            const unsigned og = xb_add(&bar[XB_TOP], 1u);
            const unsigned tg = og / nx;
            if (og + 1u == (tg + 1u) * nx) xb_add(&bar[XB_TOPGEN], 1u);
            else XB_SPIN(xb_ld(&bar[XB_TOPGEN]) == tg, bar);
            __builtin_amdgcn_fence(__ATOMIC_ACQUIRE, "agent");
            xb_add(&bar[XB_XGEN(b.x)], 1u);
            asm volatile("s_waitcnt vmcnt(0)" ::: "memory");
        } else {
            XB_SPIN(xb_ld(&bar[XB_XGEN(b.x)]) == gen, bar);
            __builtin_amdgcn_fence(__ATOMIC_ACQUIRE, "agent");
            asm volatile("s_waitcnt vmcnt(0)" ::: "memory");
        }
    }
    __syncthreads();
}

struct Frame {
    LAS unsigned char* lds;
    int tid, lane, wave, G;
    const float *x, *mem, *pre_w, *w_in, *gn_w, *memn_w, *w_kv, *w_up[3], *w_o, *post_w;
    float* out;
    bf16 *WinT, *WkvT, *WupT, *WoT, *Hb, *MemN, *KVm, *Yb, *Z, *Merged;
    float* Mrg; float* Sc;
    unsigned* Mask;
};

template <int KIND> DI int src_col(int n) { if (KIND == 0) return n < ZC_PAD ? n : (n < ZC_MQ ? -1 : n - (ZC_MQ - ZC_PAD)); return n; }
template <int KIND> DI float src_scale(int n) {
    if (KIND == 0) {
        if ((n >= ZC_RK && n < ZC_RV) || (n >= ZC_AQ && n < ZC_AK)) return 0.08838834764831845f;
        if (n >= ZC_IQ && n < ZC_IK) return 0.125f;
        if (n >= ZC_IW && n < ZC_PAD) return 0.25f;
        if (n >= ZC_MQ && n < ZC_MG) return 0.0625f;
    }
    return 1.f;
}
template <int KIND> DI void p0_transpose_item(const float* W, int K, int Nsrc, int Ndst, bf16* WT, LAS float* scr, int item, int lane) {
    const int nblk = Ndst / 64, kb = item / nblk, nb = item % nblk, k0 = 64 * kb, n0 = 64 * nb;
    const int sc = src_col<KIND>(n0 + lane); const float s = src_scale<KIND>(n0 + lane);
    const float* src = W + (size_t)k0 * Nsrc + (sc < 0 ? 0 : sc);
#pragma unroll 8
    for (int i = 0; i < 64; ++i) { const float v = src[(size_t)i * Nsrc]; scr[i * 65 + lane] = sc < 0 ? 0.f : v * s; }
    asm volatile("s_waitcnt lgkmcnt(0)" ::: "memory");
    const int c = lane & 7;
#pragma unroll
    for (int j = 0; j < 8; ++j) { const int n = (lane >> 3) + 8 * j; const LAS float* p = scr + (8 * c) * 65 + n;
        u32x4 o; o.x = pk2(p[0 * 65], p[1 * 65]); o.y = pk2(p[2 * 65], p[3 * 65]); o.z = pk2(p[4 * 65], p[5 * 65]); o.w = pk2(p[6 * 65], p[7 * 65]);
        *(u32x4*)(WT + (size_t)(n0 + n) * K + k0 + 8 * c) = o; }
    asm volatile("s_waitcnt lgkmcnt(0)" ::: "memory");
}
DI void rms_row_to_bf16(const float* xrow, const float* w, bf16* orow, float eps, int lane) {
    const f32x4* xr = (const f32x4*)xrow + lane; const f32x4* wr = (const f32x4*)w + lane;
    f32x4 v[8]; float s = 0.f;
#pragma unroll
    for (int j = 0; j < 8; ++j) { v[j] = xr[64 * j]; s += (v[j].x * v[j].x + v[j].y * v[j].y) + (v[j].z * v[j].z + v[j].w * v[j].w); }
    const float r = 1.0f / sqrtf(wave_sum(s) * (1.f / DM) + eps);
    u32x2* o8 = (u32x2*)orow + lane;
#pragma unroll
    for (int j = 0; j < 8; ++j) { const f32x4 ww = wr[64 * j]; u32x2 o; o.x = pk2(v[j].x * r * ww.x, v[j].y * r * ww.y); o.y = pk2(v[j].z * r * ww.z, v[j].w * r * ww.w); o8[64 * j] = o; }
}
DI void p0_prologue(Frame& F) {
    LAS float* scr = (LAS float*)(F.lds + F.wave * 16640);
    const int gw = blockIdx.x * NWAVES + F.wave, NGW = F.G * NWAVES;
    constexpr int I_IN = (DM / 64) * (ZLD / 64), I_KV = (DM / 64) * (2048 / 64), I_UP = (1024 / 64) * (DM / 64), I_O = (DM / 64) * (DM / 64);
    constexpr int NITEMS = I_IN + I_KV + 3 * I_UP + I_O;
    for (int it = gw; it < NITEMS; it += NGW) {
        int r = it;
        if (r < I_IN) { p0_transpose_item<0>(F.w_in, DM, NIN, ZLD, F.WinT, scr, r, F.lane); continue; } r -= I_IN;
        if (r < I_KV) { p0_transpose_item<1>(F.w_kv, DM, 2048, 2048, F.WkvT, scr, r, F.lane); continue; } r -= I_KV;
        if (r < I_UP) { p0_transpose_item<1>(F.w_up[0], 1024, DM, DM, F.WupT, scr, r, F.lane); continue; } r -= I_UP;
        if (r < I_UP) { p0_transpose_item<1>(F.w_up[1], 1024, DM, DM, F.WupT + (size_t)DM * 1024, scr, r, F.lane); continue; } r -= I_UP;
        if (r < I_UP) { p0_transpose_item<1>(F.w_up[2], 1024, DM, DM, F.WupT + (size_t)2 * DM * 1024, scr, r, F.lane); continue; } r -= I_UP;
        p0_transpose_item<1>(F.w_o, DM, DM, DM, F.WoT, scr, r, F.lane);
    }
    for (int m = gw; m < MTOK + MROWS; m += NGW) {
        if (m < MTOK) rms_row_to_bf16(F.x + (size_t)m * DM, F.pre_w, F.Hb + (size_t)m * DM, 1e-6f, F.lane);
        else rms_row_to_bf16(F.mem + (size_t)(m - MTOK) * DM, F.memn_w, F.MemN + (size_t)(m - MTOK) * DM, 1e-6f, F.lane);
    }
}


namespace pg8 {
#define PG8_LAS __attribute__((address_space(3)))
constexpr int BM = 256, BK = 64, HALF = 128, HTB = HALF * BK * 2, STAGE_BYTES = 8 * HTB, NXCD = 8, WGM = 8;
DI int lds_byte(int r, int c) { const int st = (r >> 4) * 2 + (c >> 5), rr = r & 15, cc = c & 31, ob = rr * 64 + cc * 2; return st * 1024 + (ob ^ (((ob >> 9) & 1) << 5)); }
DI void stage_rc(int b, int& R, int& C) { const int st = b / 1024, sb = b % 1024, swz = sb ^ (((sb >> 9) & 1) << 5); R = (st >> 1) * 16 + swz / 64; C = (st & 1) * 32 + (swz % 64) / 2; }
DI int perm32(int rho) { const int n = rho >> 4, i = rho & 15; return 8 * (i >> 2) + 4 * n + (i & 3); }
struct Unit { int pm, pn, w; };
struct GemmG { int lda, ldb, K; };
DI unsigned cvt_pk_bf16(float lo, float hi) { unsigned r; asm volatile("v_cvt_pk_bf16_f32 %0, %1, %2" : "=v"(r) : "v"(lo), "v"(hi)); return r; }
template <class Epi, class Sched, bool ALIGN_EPI = false, bool SP2 = false>
__device__ __forceinline__ void gemm_phase(PG8_LAS unsigned char* lds, const GemmG g, const Sched& S, const Epi& E) {
    const int tid = threadIdx.x, wid = __builtin_amdgcn_readfirstlane(tid >> 6), lane = tid & 63, wr = wid >> 2, wc = wid & 3, fr = lane & 15, fq = lane >> 4;
    const int K = g.K, nt = K / BK;
    unsigned voffA[2], voffB[2];
#pragma unroll
    for (int i = 0; i < 2; ++i) { int R, C; stage_rc(tid * 16 + i * 8192, R, C); const int Rb = Epi::PERM ? ((R & ~31) + perm32(R & 31)) : R;
        voffA[i] = (unsigned)(R * g.lda + C) * 2u; voffB[i] = (unsigned)(Rb * g.ldb + C) * 2u; }
    const size_t kstep = (size_t)(BK * 2);
    const size_t hstepA = (size_t)HALF * g.lda * 2, hstepB = (size_t)HALF * g.ldb * 2;
    const unsigned ldsw = (unsigned)wid * 1024u;
    const int aoff = lds_byte(wr * 64 + fr, fq * 8), boff = lds_byte(wc * 32 + fr, fq * 8);
#define PG8_SA(b, h) (((b) * 2 + (h)) * HTB)
#define PG8_SB(b, h) ((4 + (b) * 2 + (h)) * HTB)
#define PG8_STAGE(bufoff, gbase, voff) do { _Pragma("unroll") for (int _i = 0; _i < 2; ++_i) \
        __builtin_amdgcn_global_load_lds((const unsigned*)((const char*)(gbase) + (voff)[_i]), (PG8_LAS unsigned*)(lds + (bufoff) + ldsw + _i * 8192), 16, 0, 0); } while (0)
#define PG8_LDA(dst, b, h) do { _Pragma("unroll") for (int m = 0; m < 4; ++m) _Pragma("unroll") for (int k = 0; k < 2; ++k) dst[m][k] = *(const PG8_LAS bf16x8*)(lds + PG8_SA(b, h) + aoff + m * 2048 + k * 1024); } while (0)
#define PG8_LDB(dst, b, h) do { _Pragma("unroll") for (int n = 0; n < 2; ++n) _Pragma("unroll") for (int k = 0; k < 2; ++k) dst[n][k] = *(const PG8_LAS bf16x8*)(lds + PG8_SB(b, h) + boff + n * 2048 + k * 1024); } while (0)
#define PG8_MMA(ai, bj, At, Bt) do { __builtin_amdgcn_s_setprio(1); _Pragma("unroll") for (int m = 0; m < 4; ++m) _Pragma("unroll") for (int n = 0; n < 2; ++n) _Pragma("unroll") for (int k = 0; k < 2; ++k) \
        acc[ai][bj][m][n] = __builtin_amdgcn_mfma_f32_16x16x32_bf16(Bt[n][k], At[m][k], acc[ai][bj][m][n], 0, 0, 0); __builtin_amdgcn_s_setprio(0); } while (0)
#define PG8_WAIT_V(n) asm volatile("s_waitcnt vmcnt(" #n ")" ::: "memory")
#define PG8_WAIT_L(n) asm volatile("s_waitcnt lgkmcnt(" #n ")" ::: "memory")
#define PG8_BAR __builtin_amdgcn_s_barrier()
#define PG8_SCHED __builtin_amdgcn_sched_barrier(0)
    Unit cur, nxt; int ui = 0;
    if (!S.next(0, cur)) return;
    f32x4 acc[2][2][4][2];
#pragma unroll
    for (int a = 0; a < 2; ++a)
#pragma unroll
        for (int b = 0; b < 2; ++b)
#pragma unroll
            for (int m = 0; m < 4; ++m)
#pragma unroll
                for (int n = 0; n < 2; ++n) acc[a][b][m][n] = (f32x4){0.f, 0.f, 0.f, 0.f};
    bf16x8 At[4][2], B0[2][2], B1[2][2];
    const char* cA = S.a_ptr(cur); const char* cB = S.b_ptr(cur);
    S.a_ready(cur);
    if constexpr (SP2) {
        PG8_STAGE(PG8_SB(0, 0), cB, voffB); PG8_STAGE(PG8_SB(0, 1), cB + hstepB, voffB); PG8_STAGE(PG8_SA(0, 0), cA, voffA); PG8_STAGE(PG8_SA(0, 1), cA + hstepA, voffA);
        if (wr == 1) PG8_BAR;
        PG8_WAIT_V(2); PG8_BAR;
        PG8_STAGE(PG8_SB(1, 0), cB + kstep, voffB); PG8_STAGE(PG8_SA(1, 0), cA + kstep, voffA); PG8_STAGE(PG8_SB(1, 1), cB + hstepB + kstep, voffB);
        PG8_WAIT_V(6); PG8_BAR;
    } else {
        PG8_STAGE(PG8_SB(0, 0), cB, voffB); PG8_STAGE(PG8_SA(0, 0), cA, voffA); PG8_STAGE(PG8_SB(0, 1), cB + hstepB, voffB); PG8_STAGE(PG8_SA(0, 1), cA + hstepA, voffA);
        if (wr == 1) PG8_BAR;
        PG8_WAIT_V(4); PG8_BAR;
        PG8_STAGE(PG8_SB(1, 0), cB + kstep, voffB); PG8_STAGE(PG8_SA(1, 0), cA + kstep, voffA); PG8_STAGE(PG8_SB(1, 1), cB + hstepB + kstep, voffB);
        PG8_WAIT_V(6); PG8_BAR;
    }
    for (;;) {
        const bool has_next = S.next(ui + 1, nxt);
        const char* nA = has_next ? S.a_ptr(nxt) : cA; const char* nB = has_next ? S.b_ptr(nxt) : cB;
        for (int t = 0; t < nt; t += 2) {
            const bool last = (t == nt - 2);
            const char* a1 = cA + (size_t)(t + 1) * kstep;
            const char* a2 = last ? nA : cA + (size_t)(t + 2) * kstep; const char* b2 = last ? nB : cB + (size_t)(t + 2) * kstep;
            const char* a3 = a2 + kstep; const char* b3 = b2 + kstep;
            if (last && has_next) S.a_ready(nxt);
            if constexpr (SP2) {
            PG8_LDB(B0, 0, 0); PG8_LDB(B1, 0, 1); PG8_SCHED; PG8_LDA(At, 0, 0); PG8_STAGE(PG8_SA(1, 1), a1 + hstepA, voffA);
            PG8_WAIT_V(8); PG8_WAIT_L(0); PG8_BAR; PG8_MMA(0, 0, At, B0); PG8_MMA(0, 1, At, B1); PG8_BAR; PG8_SCHED;
            PG8_LDA(At, 0, 1); PG8_STAGE(PG8_SB(0, 0), b2, voffB); PG8_STAGE(PG8_SB(0, 1), b2 + hstepB, voffB); PG8_STAGE(PG8_SA(0, 0), a2, voffA);
            PG8_WAIT_V(8); PG8_WAIT_L(0); PG8_BAR; PG8_MMA(1, 0, At, B0); PG8_MMA(1, 1, At, B1); PG8_BAR; PG8_SCHED;
            PG8_LDB(B0, 1, 0); PG8_LDB(B1, 1, 1); PG8_SCHED; PG8_LDA(At, 1, 0); PG8_STAGE(PG8_SA(0, 1), a2 + hstepA, voffA);
            PG8_WAIT_V(8); PG8_WAIT_L(0); PG8_BAR; PG8_MMA(0, 0, At, B0); PG8_MMA(0, 1, At, B1); PG8_BAR; PG8_SCHED;
            PG8_LDA(At, 1, 1); PG8_STAGE(PG8_SB(1, 0), b3, voffB); PG8_STAGE(PG8_SB(1, 1), b3 + hstepB, voffB); PG8_STAGE(PG8_SA(1, 0), a3, voffA);
            PG8_WAIT_V(8); PG8_WAIT_L(0); PG8_BAR; PG8_MMA(1, 0, At, B0); PG8_MMA(1, 1, At, B1); PG8_BAR; PG8_SCHED;
            } else {
            PG8_LDB(B0, 0, 0); PG8_SCHED; PG8_LDA(At, 0, 0); PG8_STAGE(PG8_SA(1, 1), a1 + hstepA, voffA);
            PG8_WAIT_L(8); PG8_BAR; PG8_WAIT_L(0); PG8_MMA(0, 0, At, B0); PG8_BAR; PG8_SCHED;
            PG8_LDB(B1, 0, 1); PG8_STAGE(PG8_SB(0, 0), b2, voffB);
            PG8_BAR; PG8_WAIT_L(0); PG8_MMA(0, 1, At, B1); PG8_BAR;
            PG8_LDA(At, 0, 1); PG8_STAGE(PG8_SA(0, 0), a2, voffA);
            PG8_BAR; PG8_WAIT_L(0); PG8_MMA(1, 0, At, B0); PG8_BAR; PG8_SCHED;
            PG8_STAGE(PG8_SB(0, 1), b2 + hstepB, voffB);
            PG8_WAIT_V(6); PG8_BAR; PG8_MMA(1, 1, At, B1); PG8_BAR;
            PG8_LDB(B0, 1, 0); PG8_SCHED; PG8_LDA(At, 1, 0); PG8_STAGE(PG8_SA(0, 1), a2 + hstepA, voffA);
            PG8_WAIT_L(8); PG8_BAR; PG8_WAIT_L(0); PG8_MMA(0, 0, At, B0); PG8_BAR; PG8_SCHED;
            PG8_LDB(B1, 1, 1); PG8_STAGE(PG8_SB(1, 0), b3, voffB);
            PG8_BAR; PG8_WAIT_L(0); PG8_MMA(0, 1, At, B1); PG8_BAR;
            PG8_LDA(At, 1, 1); PG8_STAGE(PG8_SA(1, 0), a3, voffA);
            PG8_BAR; PG8_WAIT_L(0); PG8_MMA(1, 0, At, B0); PG8_BAR; PG8_SCHED;
            PG8_STAGE(PG8_SB(1, 1), b3 + hstepB, voffB);
            PG8_WAIT_V(6); PG8_BAR; PG8_MMA(1, 1, At, B1); PG8_BAR;
            }
        }
        if constexpr (ALIGN_EPI) { if (wr == 0) PG8_BAR; }
        if constexpr (!Epi::AFTER_DRAIN) { E(acc, cur, wr, wc, fr, fq); S.done(cur); }
        if (!has_next) break;
        if (!Epi::keep_acc(cur))
#pragma unroll
        for (int a = 0; a < 2; ++a)
#pragma unroll
            for (int b = 0; b < 2; ++b)
#pragma unroll
                for (int m = 0; m < 4; ++m)
#pragma unroll
                    for (int n = 0; n < 2; ++n) acc[a][b][m][n] = (f32x4){0.f, 0.f, 0.f, 0.f};
        cur = nxt; cA = nA; cB = nB; ++ui;
        if constexpr (ALIGN_EPI) { if (wr == 1) PG8_BAR; }
    }
    PG8_WAIT_V(0);
    if constexpr (!ALIGN_EPI) { if (wr == 0) PG8_BAR; }
    PG8_BAR;
    if constexpr (Epi::AFTER_DRAIN) { E.fused(acc, cur, wr, wc, fr, fq, lds, wid, lane); S.done(cur); }
#undef PG8_SA
#undef PG8_SB
#undef PG8_STAGE
#undef PG8_LDA
#undef PG8_LDB
#undef PG8_MMA
#undef PG8_WAIT_V
#undef PG8_WAIT_L
#undef PG8_BAR
#undef PG8_SCHED
}

}


namespace pg8 {
struct EpiZ {
    static constexpr bool PERM = true, AFTER_DRAIN = false; static DI bool keep_acc(const Unit&) { return false; }
    bf16* Z; bf16* KV;
    DI void operator()(f32x4 (&acc)[2][2][4][2], const Unit& u, int wr, int wc, int fr, int fq) const {
        bf16* base = u.w ? KV : Z; const int ld = u.w ? 2048 : ZLD;
        const int row0 = u.pm * BM + wr * 64 + fr, col0 = u.pn * BM + wc * 32 + 8 * fq;
        const bool ret = (u.w == 0) && (u.pn < 8);
        float lg2[2] = {0.f, 0.f};
        if (ret) {
#pragma unroll
            for (int bj = 0; bj < 2; ++bj) { const int hd = 2 * (u.pn & 3) + bj; lg2[bj] = log2f(1.f - exp2f(-5.f - (float)hd)) * (u.pn < 4 ? 1.f : -1.f); } }
#pragma unroll
        for (int ai = 0; ai < 2; ++ai)
#pragma unroll
            for (int m = 0; m < 4; ++m) { const int row = row0 + ai * HALF + m * 16; bf16* rowp = base + (size_t)row * ld + col0;
#pragma unroll
                for (int bj = 0; bj < 2; ++bj) { f32x4 v0 = acc[ai][bj][m][0], v1 = acc[ai][bj][m][1];
                    if (ret) { const float sc = __builtin_amdgcn_exp2f((float)(row & (SEQ - 1)) * lg2[bj]); v0 = v0 * sc; v1 = v1 * sc; }
                    u32x4 w; w.x = cvt_pk_bf16(v0[0], v0[1]); w.y = cvt_pk_bf16(v0[2], v0[3]); w.z = cvt_pk_bf16(v1[0], v1[1]); w.w = cvt_pk_bf16(v1[2], v1[3]);
                    *(u32x4*)(rowp + bj * HALF) = w; } }
    }
};
DI float expneg_c(float g) { return __expf(-fminf(fmaxf(g, -60.f), 60.f)); }
struct EpiGate {
    static constexpr bool PERM = true, AFTER_DRAIN = false; static DI bool keep_acc(const Unit& u) { return u.w < 2; }
    const bf16* Z; bf16* Out;
    DI void operator()(f32x4 (&acc)[2][2][4][2], const Unit& u, int wr, int wc, int fr, int fq) const {
        const int b = u.w;
        const int row0 = u.pm * BM + wr * 64 + fr, col0 = u.pn * BM + wc * 32 + 8 * fq;
        const bf16* ga = Z + ZC_GR + 2048 * b; const bf16* gb = ga + 2048;
#pragma unroll
        for (int ai = 0; ai < 2; ++ai)
#pragma unroll
            for (int m = 0; m < 4; ++m) { const size_t roff = (size_t)(row0 + ai * HALF + m * 16);
#pragma unroll
                for (int bj = 0; bj < 2; ++bj) { const int col = col0 + bj * HALF;
                    const u32x4 a = *(const u32x4*)(ga + roff * ZLD + col);
                    float ea[8] = {expneg_c(bflo(a.x)), expneg_c(bfhi(a.x)), expneg_c(bflo(a.y)), expneg_c(bfhi(a.y)), expneg_c(bflo(a.z)), expneg_c(bfhi(a.z)), expneg_c(bflo(a.w)), expneg_c(bfhi(a.w))};
                    float f[8];
                    if (b < 2) { const u32x4 c = *(const u32x4*)(gb + roff * ZLD + col);
                        const float eb[8] = {expneg_c(bflo(c.x)), expneg_c(bfhi(c.x)), expneg_c(bflo(c.y)), expneg_c(bfhi(c.y)), expneg_c(bflo(c.z)), expneg_c(bfhi(c.z)), expneg_c(bflo(c.w)), expneg_c(bfhi(c.w))};
#pragma unroll
                        for (int e = 0; e < 8; ++e) f[e] = (1.f + eb[e]) * __builtin_amdgcn_rcpf(1.f + ea[e]);
                    } else {
#pragma unroll
                        for (int e = 0; e < 8; ++e) f[e] = __builtin_amdgcn_rcpf(1.f + ea[e]);
                    }
                    f32x4 v0 = acc[ai][bj][m][0], v1 = acc[ai][bj][m][1];
                    v0[0] *= f[0]; v0[1] *= f[1]; v0[2] *= f[2]; v0[3] *= f[3]; v1[0] *= f[4]; v1[1] *= f[5]; v1[2] *= f[6]; v1[3] *= f[7];
                    if (b < 2) { acc[ai][bj][m][0] = v0; acc[ai][bj][m][1] = v1; }
                    else { u32x4 w; w.x = cvt_pk_bf16(v0[0], v0[1]); w.y = cvt_pk_bf16(v0[2], v0[3]); w.z = cvt_pk_bf16(v1[0], v1[1]); w.w = cvt_pk_bf16(v1[2], v1[3]);
                        *(u32x4*)(Out + roff * DM + col) = w; } } }
    }
};
struct EpiOutF32 {
    static constexpr bool PERM = true, AFTER_DRAIN = false; static DI bool keep_acc(const Unit&) { return false; }
    float* O;
    DI void operator()(f32x4 (&acc)[2][2][4][2], const Unit& u, int wr, int wc, int fr, int fq) const {
        const int row0 = u.pm * BM + wr * 64 + fr, col0 = u.pn * BM + wc * 32 + 8 * fq;
#pragma unroll
        for (int ai = 0; ai < 2; ++ai)
#pragma unroll
            for (int m = 0; m < 4; ++m) { float* rowp = O + (size_t)(row0 + ai * HALF + m * 16) * DM + col0;
#pragma unroll
                for (int bj = 0; bj < 2; ++bj) { *(f32x4*)(rowp + bj * HALF) = acc[ai][bj][m][0]; *(f32x4*)(rowp + bj * HALF + 4) = acc[ai][bj][m][1]; } }
    }
};
struct SchedP1 {
    int G, c; const char *A0, *B0, *A1, *B1;
    static constexpr int nM = MTOK / BM, nN = ZLD / BM, nwg = nM * nN, NKV = (MROWS / BM) * (2048 / BM);
    DI bool next(int i, Unit& u) const {
        const long L = (long)i * G + c; if (L >= nwg + NKV) return false;
        const int k = (int)L - nwg; const bool kv = k >= 0;
        int wgid = kv ? 0 : (int)L; { const int q = nwg / NXCD, r = nwg % NXCD, xcd = wgid % NXCD, off = wgid / NXCD; wgid = (xcd < r ? xcd * (q + 1) : r * (q + 1) + (xcd - r) * q) + off; }
        const int nig = WGM * nN, gid = wgid / nig, fm = gid * WGM, gsz = (nM - fm) < WGM ? (nM - fm) : WGM;
        const int pm0 = fm + ((wgid % nig) % gsz), pn0 = (wgid % nig) / gsz;
        Unit r_; r_.pm = kv ? (k & 3) : pm0; r_.pn = kv ? (k >> 2) : pn0; r_.w = kv ? 1 : 0; u = r_; return true;
    }
    DI const char* a_ptr(const Unit& u) const { return (u.w ? A1 : A0) + (size_t)u.pm * ((size_t)BM * DM * 2); }
    DI const char* b_ptr(const Unit& u) const { return (u.w ? B1 : B0) + (size_t)u.pn * ((size_t)BM * DM * 2); }
    DI void a_ready(const Unit&) const {}
    DI void done(const Unit&) const {}
};
struct SchedTile {
    int G, c, nb; const char *A, *B; size_t sAb, sBb; int lda, ldb;
    DI bool next(int i, Unit& u) const {
        const int T = (i / nb) * G + c; if (T >= 256) return false;
        const int xcd = T & 7, j = T >> 3; Unit r_; r_.w = i % nb; r_.pm = xcd * 4 + (j & 3); r_.pn = j >> 2; u = r_; return true;
    }
    DI const char* a_ptr(const Unit& u) const { return A + (size_t)u.w * sAb + (size_t)u.pm * ((size_t)BM * lda * 2); }
    DI const char* b_ptr(const Unit& u) const { return B + (size_t)u.w * sBb + (size_t)u.pn * ((size_t)BM * ldb * 2); }
    DI void a_ready(const Unit&) const {}
    DI void done(const Unit&) const {}
};
}

template <class Epi> DI void simple_gemm(Frame& F, const bf16* A, int lda, const bf16* Bt, int ldb, int M, int N, int K, const Epi& E) {
    const int wr = F.wave >> 2, wc = F.wave & 3, fr = F.lane & 15, fq = F.lane >> 4;
    const int ntn = N / 128, ntiles = (M / 128) * ntn;
    for (int t = blockIdx.x; t < ntiles; t += F.G) {
        const int tm = t / ntn, tn = t % ntn;
        const int row0 = tm * 128 + wr * 64, col0 = tn * 128 + wc * 32;
        f32x4 acc[4][2];
#pragma unroll
        for (int m = 0; m < 4; ++m)
#pragma unroll
            for (int n = 0; n < 2; ++n) acc[m][n] = (f32x4){0.f, 0.f, 0.f, 0.f};
        const bf16* ap = A + (size_t)(row0 + fr) * lda + 8 * fq;
        const bf16* bp = Bt + (size_t)(col0 + fr) * ldb + 8 * fq;
        for (int k0 = 0; k0 < K; k0 += 32) {
            bf16x8 a[4], b[2];
#pragma unroll
            for (int m = 0; m < 4; ++m) a[m] = *(const bf16x8*)(ap + (size_t)(16 * m) * lda + k0);
#pragma unroll
            for (int n = 0; n < 2; ++n) b[n] = *(const bf16x8*)(bp + (size_t)(16 * n) * ldb + k0);
#pragma unroll
            for (int m = 0; m < 4; ++m)
#pragma unroll
                for (int n = 0; n < 2; ++n) acc[m][n] = __builtin_amdgcn_mfma_f32_16x16x32_bf16(b[n], a[m], acc[m][n], 0, 0, 0);
        }
#pragma unroll
        for (int m = 0; m < 4; ++m)
#pragma unroll
            for (int n = 0; n < 2; ++n) E(row0 + 16 * m + fr, col0 + 16 * n + 4 * fq, acc[m][n]);
    }
}
struct EpiBf16Store { bf16* O; int ld;
    DI void operator()(int row, int col, f32x4 v) const { u32x2 o; o.x = pk2(v.x, v.y); o.y = pk2(v.z, v.w); *(u32x2*)(O + (size_t)row * ld + col) = o; } };
template <int MODE> struct EpiGate { const bf16* G; float* Mrg; bf16* Out;
    DI void operator()(int row, int col, f32x4 v) const {
        const u32x2 g = *(const u32x2*)(G + (size_t)row * ZLD + col);
        f32x4 r; r.x = sigmoid_f(bflo(g.x)) * v.x; r.y = sigmoid_f(bfhi(g.x)) * v.y; r.z = sigmoid_f(bflo(g.y)) * v.z; r.w = sigmoid_f(bfhi(g.y)) * v.w;
        float* mp = Mrg + (size_t)row * DM + col;
        if (MODE >= 1) r = r + *(const f32x4*)mp;
        if (MODE <= 1) *(f32x4*)mp = r;
        else { u32x2 o; o.x = pk2(r.x, r.y); o.y = pk2(r.z, r.w); *(u32x2*)(Out + (size_t)row * DM + col) = o; }
    } };
struct EpiF32Store { float* O; int ld;
    DI void operator()(int row, int col, f32x4 v) const { *(f32x4*)(O + (size_t)row * ld + col) = v; } };

DI unsigned okey(float f) { const unsigned u = __builtin_bit_cast(unsigned, f); return (u & 0x80000000u) ? ~u : (u | 0x80000000u); }

DI void p_indexer_naive(Frame& F) {
    LAS float* qf = (LAS float*)F.lds;
    LAS float* wf = qf + 1024;
    LAS float* sc = qf + 1024 + 64;
    LAS int* red = (LAS int*)(sc + 2048);
    const int tid = F.tid;
    for (int t = blockIdx.x; t < MTOK; t += F.G) {
        const int b = t / SEQ, i = t % SEQ;
        const bf16* zrow = F.Z + (size_t)t * ZLD;
        for (int e = tid; e < 1024; e += NTHR) qf[e] = bf2f(zrow[ZC_IQ + e]);
        if (tid < 16) wf[tid] = bf2f(zrow[ZC_IW + tid]);
        __syncthreads();
        for (int s = tid; s <= i; s += NTHR) {
            const u32x4* kp = (const u32x4*)(F.Z + (size_t)(b * SEQ + s) * ZLD + ZC_IK);
            float kf[64];
#pragma unroll
            for (int c = 0; c < 8; ++c) { const u32x4 w = kp[c];
                kf[8 * c + 0] = bflo(w.x); kf[8 * c + 1] = bfhi(w.x); kf[8 * c + 2] = bflo(w.y); kf[8 * c + 3] = bfhi(w.y);
                kf[8 * c + 4] = bflo(w.z); kf[8 * c + 5] = bfhi(w.z); kf[8 * c + 6] = bflo(w.w); kf[8 * c + 7] = bfhi(w.w); }
            float score = 0.f;
            for (int h = 0; h < 16; ++h) { float d = 0.f;
#pragma unroll
                for (int e = 0; e < 64; ++e) d += qf[h * 64 + e] * kf[e];
                score += wf[h] * fmaxf(d, 0.f); }
            sc[s] = score;
        }
        __syncthreads();
        const int n = i + 1;
        unsigned T = 0u;
        if (n > TOPK) {
            for (int bit = 31; bit >= 0; --bit) {
                const unsigned cand = T | (1u << bit);
                int cnt = 0;
                for (int s = tid; s <= i; s += NTHR) cnt += (okey(sc[s]) >= cand) ? 1 : 0;
                cnt = wave_sum_i(cnt);
                if (F.lane == 0) red[F.wave] = cnt;
                __syncthreads();
                int tot = 0;
#pragma unroll
                for (int w = 0; w < 8; ++w) tot += red[w];
                __syncthreads();
                if (tot >= TOPK) T = cand;
            }
        }
        if (tid < 64) { unsigned w = 0u;
            for (int j = 0; j < 32; ++j) { const int s = 32 * tid + j; if (s <= i && (n <= TOPK || okey(sc[s]) >= T)) w |= (1u << j); }
            F.Mask[(size_t)t * 64 + tid] = w; }
        __syncthreads();
    }
}

DI void p_dsa_naive(Frame& F) {
    LAS int* sel = (LAS int*)F.lds;
    LAS int* cw = sel + 320;
    LAS float* lg = (LAS float*)(cw + 80);
    const int tid = F.tid, lane = F.lane, h = F.wave;
    bf16* Y = F.Yb + (size_t)MTOK * 1024;
    for (int t = blockIdx.x; t < MTOK; t += F.G) {
        const int b = t / SEQ, i = t % SEQ;
        unsigned mw = 0u;
        if (tid < 64) { mw = F.Mask[(size_t)t * 64 + tid]; cw[tid] = __popc(mw); }
        __syncthreads();
        if (tid == 0) { int run = 0; for (int k = 0; k < 64; ++k) { const int c = cw[k]; cw[k] = run; run += c; } cw[64] = run; }
        __syncthreads();
        if (tid < 64) { int o = cw[tid]; unsigned w = mw; while (w) { const int j = __ffs(w) - 1; w &= w - 1u; if (o < 320) sel[o] = 32 * tid + j; ++o; } }
        __syncthreads();
        const int nsel = cw[64] < 320 ? cw[64] : 320;
        const bf16* zrow = F.Z + (size_t)t * ZLD;
        const unsigned qw = *(const unsigned*)(zrow + ZC_AQ + h * 128 + 2 * lane);
        const float q0 = bflo(qw), q1 = bfhi(qw);
        const float slope = exp2f(-(float)(h + 1));
        float mx = -1e30f;
        for (int idx = 0; idx < nsel; ++idx) {
            const int j = sel[idx];
            const unsigned kw = *(const unsigned*)(F.Z + (size_t)(b * SEQ + j) * ZLD + ZC_AK + h * 128 + 2 * lane);
            const float d = wave_sum(q0 * bflo(kw) + q1 * bfhi(kw));
            const float l = d - slope * (float)(i - j);
            if (lane == 0) lg[h * 320 + idx] = l;
            mx = fmaxf(mx, l);
        }
        float sum = 0.f;
        for (int idx = lane; idx < nsel; idx += 64) sum += __expf(lg[h * 320 + idx] - mx);
        sum = wave_sum(sum);
        const float inv = 1.f / sum;
        float a0 = 0.f, a1 = 0.f;
        for (int idx = 0; idx < nsel; ++idx) {
            const int j = sel[idx];
            const float p = __expf(lg[h * 320 + idx] - mx) * inv;
            const unsigned vw = *(const unsigned*)(F.Z + (size_t)(b * SEQ + j) * ZLD + ZC_AV + h * 128 + 2 * lane);
            a0 += p * bflo(vw); a1 += p * bfhi(vw);
        }
        const unsigned gw = *(const unsigned*)(zrow + ZC_AG + h * 128 + 2 * lane);
        *(unsigned*)(Y + (size_t)t * 1024 + h * 128 + 2 * lane) = pk2(silu_f(bflo(gw)) * a0, silu_f(bfhi(gw)) * a1);
        __syncthreads();
    }
}

DI void p_ret_naive(Frame& F) {
    const int lane = F.lane, h = F.wave;
    const float log_g = log1pf(-exp2f(-5.f - (float)h));
    for (int t = blockIdx.x; t < MTOK; t += F.G) {
        const int b = t / SEQ, i = t % SEQ;
        const bf16* zrow = F.Z + (size_t)t * ZLD;
        const unsigned qw = *(const unsigned*)(zrow + ZC_RQ + h * 128 + 2 * lane);
        const float q0 = bflo(qw), q1 = bfhi(qw);
        float a0 = 0.f, a1 = 0.f;
        for (int j = 0; j <= i; ++j) {
            const bf16* kr = F.Z + (size_t)(b * SEQ + j) * ZLD;
            const unsigned kw = *(const unsigned*)(kr + ZC_RK + h * 128 + 2 * lane);
            const unsigned vw = *(const unsigned*)(kr + ZC_RV + h * 128 + 2 * lane);
            const float d = wave_sum(q0 * bflo(kw) + q1 * bfhi(kw)) * __expf(log_g * (float)(i - j));
            a0 += d * bflo(vw); a1 += d * bfhi(vw);
        }
        const float mean = wave_sum(a0 + a1) * (1.f / 128.f);
        const float d0 = a0 - mean, d1 = a1 - mean;
        const float var = wave_sum(d0 * d0 + d1 * d1) * (1.f / 128.f);
        const float rs = 1.0f / sqrtf(var + 1e-5f);
        const float w0 = F.gn_w[h * 128 + 2 * lane], w1 = F.gn_w[h * 128 + 2 * lane + 1];
        const unsigned gw = *(const unsigned*)(zrow + ZC_RG + h * 128 + 2 * lane);
        *(unsigned*)(F.Yb + (size_t)t * 1024 + h * 128 + 2 * lane) = pk2(silu_f(bflo(gw)) * d0 * rs * w0, silu_f(bfhi(gw)) * d1 * rs * w1);
    }
}

DI void p_mem_naive(Frame& F) {
    LAS float* lg = (LAS float*)F.lds;
    const int lane = F.lane, w = F.wave, hh = w & 3;
    bf16* Y = F.Yb + (size_t)2 * MTOK * 1024;
    for (int t2 = blockIdx.x; t2 < MTOK / 2; t2 += F.G) {
        const int t = 2 * t2 + (w >> 2), b = t / SEQ;
        const bf16* zrow = F.Z + (size_t)t * ZLD;
        const u32x2 qw = *(const u32x2*)(zrow + ZC_MQ + hh * 256 + 4 * lane);
        const float q0 = bflo(qw.x), q1 = bfhi(qw.x), q2 = bflo(qw.y), q3 = bfhi(qw.y);
        float mx = -1e30f;
        for (int m = 0; m < MEMT; ++m) {
            const u32x2 kw = *(const u32x2*)(F.KVm + (size_t)(b * MEMT + m) * 2048 + hh * 256 + 4 * lane);
            const float d = wave_sum(q0 * bflo(kw.x) + q1 * bfhi(kw.x) + q2 * bflo(kw.y) + q3 * bfhi(kw.y));
            if (lane == 0) lg[w * 256 + m] = d;
            mx = fmaxf(mx, d);
        }
        float sum = 0.f;
        for (int m = lane; m < MEMT; m += 64) sum += __expf(lg[w * 256 + m] - mx);
        sum = wave_sum(sum);
        const float inv = 1.f / sum;
        float a0 = 0.f, a1 = 0.f, a2 = 0.f, a3 = 0.f;
        for (int m = 0; m < MEMT; ++m) {
            const float p = __expf(lg[w * 256 + m] - mx) * inv;
            const u32x2 vw = *(const u32x2*)(F.KVm + (size_t)(b * MEMT + m) * 2048 + 1024 + hh * 256 + 4 * lane);
            a0 += p * bflo(vw.x); a1 += p * bfhi(vw.x); a2 += p * bflo(vw.y); a3 += p * bfhi(vw.y);
        }
        const u32x2 gw = *(const u32x2*)(zrow + ZC_MG + hh * 256 + 4 * lane);
        u32x2 o; o.x = pk2(silu_f(bflo(gw.x)) * a0, silu_f(bfhi(gw.x)) * a1); o.y = pk2(silu_f(bflo(gw.y)) * a2, silu_f(bfhi(gw.y)) * a3);
        *(u32x2*)(Y + (size_t)t * 1024 + hh * 256 + 4 * lane) = o;
    }
}

DI void p_final(Frame& F) {
    const int gw = blockIdx.x * NWAVES + F.wave, NGW = F.G * NWAVES, lane = F.lane;
    for (int m = gw; m < MTOK; m += NGW) {
        f32x4* orow = (f32x4*)(F.out + (size_t)m * DM) + lane; const f32x4* xr = (const f32x4*)(F.x + (size_t)m * DM) + lane; const f32x4* wr = (const f32x4*)F.post_w + lane;
        f32x4 v[8]; float s = 0.f;
#pragma unroll
        for (int j = 0; j < 8; ++j) { v[j] = orow[64 * j]; s += (v[j].x * v[j].x + v[j].y * v[j].y) + (v[j].z * v[j].z + v[j].w * v[j].w); }
        const float r = 1.0f / sqrtf(wave_sum(s) * (1.f / DM) + 1e-6f);
#pragma unroll
        for (int j = 0; j < 8; ++j) orow[64 * j] = xr[64 * j] + v[j] * r * wr[64 * j];
    }
}


namespace att {
typedef float f32x16 __attribute__((ext_vector_type(16)));
typedef short v4i16_t __attribute__((ext_vector_type(4)));
typedef __bf16 bf16x2_t __attribute__((ext_vector_type(2)));
typedef float f32x2_t __attribute__((ext_vector_type(2)));
constexpr float LOG2E = 1.4426950408889634f;
DI unsigned off_b(unsigned row, unsigned ch) { return 256u * row + 16u * (ch ^ (((row & 3) << 2) | ((row >> 2) & 3))); }
DI f32x16 mfma32(bf16x8 a, bf16x8 b, f32x16 c) { return __builtin_amdgcn_mfma_f32_32x32x16_bf16(a, b, c, 0, 0, 0); }
DI unsigned cvtpk(float lo, float hi) { f32x2_t v = {lo, hi}; bf16x2_t o = __builtin_convertvector(v, bf16x2_t); return __builtin_bit_cast(unsigned, o); }
DI v4i16_t vtr(unsigned addr) { return __builtin_amdgcn_ds_read_tr16_b64_v4i16((LAS v4i16_t*)(uintptr_t)addr); }
DI bf16x8 pack8(const f32x16& x, int s) { u32x4 p; p.x = cvtpk(x[8 * s + 0], x[8 * s + 1]); p.y = cvtpk(x[8 * s + 2], x[8 * s + 3]); p.z = cvtpk(x[8 * s + 4], x[8 * s + 5]); p.w = cvtpk(x[8 * s + 6], x[8 * s + 7]); return __builtin_bit_cast(bf16x8, p); }

template <int MODE> DI void attn_unit(Frame& F, int b, int h, int qb) {
    const int tid = F.tid, lane = F.lane, w = F.wave, r = lane & 31, hh = lane >> 5;
    const int q0 = qb * 256, qrow = q0 + 32 * w + r, qt = 8 * qb + w;
    constexpr int zq = MODE ? ZC_AQ : ZC_RQ, zk = MODE ? ZC_AK : ZC_RK, zv = MODE ? ZC_AV : ZC_RV, zg = MODE ? ZC_AG : ZC_RG;
    const bf16* Zb = F.Z + (size_t)b * SEQ * ZLD;
    const unsigned ldsb = (unsigned)(uintptr_t)F.lds;
    bf16x8 qf[8];
    { const bf16* qp = Zb + (size_t)qrow * ZLD + zq + h * 128 + 8 * hh;
#pragma unroll
      for (int ks = 0; ks < 8; ++ks) qf[ks] = *(const bf16x8*)(qp + 16 * ks); }
    const int srow = tid >> 4, sch = tid & 15;
    const bf16* kg = Zb + (size_t)srow * ZLD + zk + h * 128 + sch * 8;
    const bf16* vg = Zb + (size_t)srow * ZLD + zv + h * 128 + sch * 8;
    const unsigned lo0 = off_b(srow, sch), lo1 = off_b(srow + 32, sch);
    unsigned kaddr[8], vaddr[4][2];
#pragma unroll
    for (int ks = 0; ks < 8; ++ks) kaddr[ks] = off_b(r, 2 * ks + hh);
    { const unsigned blk = (lane >> 4) & 1, q = (lane & 15) >> 2, p = lane & 3;
#pragma unroll
      for (int c = 0; c < 4; ++c)
#pragma unroll
        for (int t = 0; t < 2; ++t) vaddr[c][t] = off_b(8 * t + 4 * hh + q, 4 * c + 2 * blk + (p >> 1)) + 8 * (p & 1); }
    const unsigned* mrow = F.Mask + (size_t)(b * SEQ + qrow) * 64;
    const float slope2 = exp2f(-(float)(h + 1)) * LOG2E;
    f32x16 o[4];
#pragma unroll
    for (int c = 0; c < 4; ++c)
#pragma unroll
        for (int i = 0; i < 16; ++i) o[c][i] = 0.f;
    float m = -1e30f, l = 0.f;
    const int nst = 4 * (qb + 1);
    u32x4 kr0, kr1, vr0, vr1; u32x2 mw = {0u, 0u}, mwn = {0u, 0u};
    kr0 = *(const u32x4*)kg; kr1 = *(const u32x4*)(kg + (size_t)32 * ZLD); vr0 = *(const u32x4*)vg; vr1 = *(const u32x4*)(vg + (size_t)32 * ZLD);
    if (MODE) mw = *(const u32x2*)mrow;
    *(LAS u32x4*)(F.lds + lo0) = kr0; *(LAS u32x4*)(F.lds + lo1) = kr1; *(LAS u32x4*)(F.lds + 32768 + lo0) = vr0; *(LAS u32x4*)(F.lds + 32768 + lo1) = vr1;
    __syncthreads();
    for (int st = 0; st < nst; ++st) {
        const int cur = st & 1; const bool more = (st + 1 < nst);
        if (more) { const size_t go = (size_t)(64 * (st + 1)) * ZLD;
            kr0 = *(const u32x4*)(kg + go); kr1 = *(const u32x4*)(kg + go + (size_t)32 * ZLD); vr0 = *(const u32x4*)(vg + go); vr1 = *(const u32x4*)(vg + go + (size_t)32 * ZLD);
            if (MODE) mwn = *(const u32x2*)(mrow + 2 * (st + 1)); }
        const unsigned kb = ldsb + cur * 16384, vb = ldsb + 32768 + cur * 16384;
#pragma unroll
        for (int tt = 0; tt < 2; ++tt) {
            const int kt = 2 * st + tt;
            if (kt <= qt) {
                f32x16 s;
#pragma unroll
                for (int i = 0; i < 16; ++i) s[i] = 0.f;
#pragma unroll
                for (int ks = 0; ks < 8; ++ks) { const bf16x8 kf = *(const LAS bf16x8*)(uintptr_t)(kb + tt * 8192 + kaddr[ks]); s = mfma32(kf, qf[ks], s); }
                if (MODE) {
                    const unsigned mv = (tt ? mw.y : mw.x) >> (4 * hh);
                    const float tb = slope2 * (float)(32 * kt + 4 * hh - qrow);
                    float mt = -1e30f;
#pragma unroll
                    for (int i = 0; i < 16; ++i) { const int ci = (i & 3) + 8 * (i >> 2);
                        float lg = __builtin_fmaf(slope2, (float)ci, __builtin_fmaf(s[i], LOG2E, tb));
                        lg = ((mv >> ci) & 1u) ? lg : -1e30f; s[i] = lg; mt = fmaxf(mt, lg); }
                    mt = fmaxf(mt, __shfl_xor(mt, 32));
                    const float mn = fmaxf(m, mt), alpha = __builtin_amdgcn_exp2f(m - mn); m = mn;
                    float ps = 0.f;
#pragma unroll
                    for (int i = 0; i < 16; ++i) { const float p = __builtin_amdgcn_exp2f(s[i] - mn); s[i] = p; ps += p; }
                    l = l * alpha + ps;
                    if (__any(alpha != 1.f)) {
#pragma unroll
                        for (int c = 0; c < 4; ++c)
#pragma unroll
                            for (int i = 0; i < 16; ++i) o[c][i] *= alpha; }
                } else {
                    if (kt == qt) {
#pragma unroll
                        for (int i = 0; i < 16; ++i) { const int ci = (i & 3) + 8 * (i >> 2); s[i] = (ci + 4 * hh <= r) ? s[i] : 0.f; } }
                }
                const bf16x8 pf0 = pack8(s, 0), pf1 = pack8(s, 1);
#pragma unroll
                for (int c = 0; c < 4; ++c) {
                    const unsigned va = vb + tt * 8192;
                    const v4i16_t a00 = vtr(va + vaddr[c][0]), a01 = vtr(va + vaddr[c][1]), a10 = vtr(va + 4096 + vaddr[c][0]), a11 = vtr(va + 4096 + vaddr[c][1]);
                    const bf16x8 A0 = {a00[0], a00[1], a00[2], a00[3], a01[0], a01[1], a01[2], a01[3]};
                    const bf16x8 A1 = {a10[0], a10[1], a10[2], a10[3], a11[0], a11[1], a11[2], a11[3]};
                    o[c] = mfma32(A0, pf0, o[c]); o[c] = mfma32(A1, pf1, o[c]);
                }
            }
        }
        if (more) { const unsigned nb = (cur ^ 1) * 16384;
            *(LAS u32x4*)(F.lds + nb + lo0) = kr0; *(LAS u32x4*)(F.lds + nb + lo1) = kr1; *(LAS u32x4*)(F.lds + 32768 + nb + lo0) = vr0; *(LAS u32x4*)(F.lds + 32768 + nb + lo1) = vr1;
            if (MODE) mw = mwn; }
        __syncthreads();
    }
    const bf16* grow = Zb + (size_t)qrow * ZLD + zg + h * 128 + 4 * hh;
    bf16* yrow = F.Yb + (size_t)(MODE ? MTOK : 0) * 1024 + (size_t)(b * SEQ + qrow) * 1024 + h * 128 + 4 * hh;
    if (MODE) {
        const float lt = l + __shfl_xor(l, 32), inv = 1.f / lt;
#pragma unroll
        for (int c = 0; c < 4; ++c)
#pragma unroll
            for (int g = 0; g < 4; ++g) { const int d0 = 32 * c + 8 * g; const u32x2 gw = *(const u32x2*)(grow + d0);
                u32x2 ov; ov.x = pk2(silu_f(bflo(gw.x)) * o[c][4 * g + 0] * inv, silu_f(bfhi(gw.x)) * o[c][4 * g + 1] * inv);
                ov.y = pk2(silu_f(bflo(gw.y)) * o[c][4 * g + 2] * inv, silu_f(bfhi(gw.y)) * o[c][4 * g + 3] * inv);
                *(u32x2*)(yrow + d0) = ov; }
    } else {
        float sm = 0.f;
#pragma unroll
        for (int c = 0; c < 4; ++c)
#pragma unroll
            for (int i = 0; i < 16; ++i) sm += o[c][i];
        sm += __shfl_xor(sm, 32);
        const float mean = sm * (1.f / 128.f);
        float sv = 0.f;
#pragma unroll
        for (int c = 0; c < 4; ++c)
#pragma unroll
            for (int i = 0; i < 16; ++i) { const float d = o[c][i] - mean; sv += d * d; }
        sv += __shfl_xor(sv, 32);
        const float rs = 1.0f / sqrtf(sv * (1.f / 128.f) + 1e-5f);
        const float* gnw = F.gn_w + h * 128 + 4 * hh;
#pragma unroll
        for (int c = 0; c < 4; ++c)
#pragma unroll
            for (int g = 0; g < 4; ++g) { const int d0 = 32 * c + 8 * g; const u32x2 gw = *(const u32x2*)(grow + d0); const f32x4 wv = *(const f32x4*)(gnw + d0);
                u32x2 ov; ov.x = pk2(silu_f(bflo(gw.x)) * (o[c][4 * g + 0] - mean) * rs * wv.x, silu_f(bfhi(gw.x)) * (o[c][4 * g + 1] - mean) * rs * wv.y);
                ov.y = pk2(silu_f(bflo(gw.y)) * (o[c][4 * g + 2] - mean) * rs * wv.z, silu_f(bfhi(gw.y)) * (o[c][4 * g + 3] - mean) * rs * wv.w);
                *(u32x2*)(yrow + d0) = ov; }
    }
}
DI void p_attn(Frame& F) {
    for (int it = blockIdx.x; it < 256; it += F.G) {
        const int xcd = it & 7, j = it >> 3, bh = xcd * 4 + (j >> 3), qb = j & 7, b = bh >> 3, h = bh & 7;
        attn_unit<1>(F, b, h, qb);
        attn_unit<0>(F, b, h, 7 - qb);
    }
}
}


namespace idx {
using att::f32x16; using att::mfma32;
constexpr int QIMG = 0, WOFF = 65536;
DI unsigned off_q(unsigned row, unsigned ch) { return 2048u * row + 16u * (ch ^ (((row & 3) << 2) | ((row >> 2) & 3))); }
DI float cand_f(unsigned c) { return __builtin_bit_cast(float, (c & 0x80000000u) ? (c & 0x7fffffffu) : ~c); }

DI void idx_unit(Frame& F, int b, int qi) {
    const int tid = F.tid, lane = F.lane, w = F.wave, r = lane & 31, hh = lane >> 5;
    const bf16* Zb = F.Z + (size_t)b * SEQ * ZLD;
    const int q0 = 32 * qi;
    const unsigned ldsb = (unsigned)(uintptr_t)F.lds;
    float* Sc = F.Sc + (size_t)(b * SEQ + q0) * SEQ;
#pragma unroll
    for (int i = 0; i < 8; ++i) { const int n = tid + 512 * i, row = n >> 7, ch = n & 127;
        const u32x4 v = *(const u32x4*)(Zb + (size_t)(q0 + row) * ZLD + ZC_IQ + ch * 8); *(LAS u32x4*)(F.lds + QIMG + off_q(row, ch)) = v; }
    { const int row = tid >> 4, hd = tid & 15; ((LAS float*)(F.lds + WOFF))[row * 17 + hd] = bf2f(Zb[(size_t)(q0 + row) * ZLD + ZC_IW + hd]); }
    __syncthreads();
    const unsigned fx = (((r & 3) << 2) | ((r >> 2) & 3)) ^ hh;
    const unsigned qbase = ldsb + QIMG + 2048u * r;
    const LAS float* wl = (const LAS float*)(F.lds + WOFF) + r * 17;
#pragma unroll 1
    for (int kt = w; kt <= qi; kt += 16) {
        const bf16* ka_p = Zb + (size_t)(32 * kt + r) * ZLD + ZC_IK + 8 * hh;
        const bf16* kb_p = ka_p + (size_t)256 * ZLD;
        bf16x8 ka[4], kb[4];
#pragma unroll
        for (int ks = 0; ks < 4; ++ks) { ka[ks] = *(const bf16x8*)(ka_p + 16 * ks); kb[ks] = *(const bf16x8*)(kb_p + 16 * ks); }
        f32x16 sca, scb;
#pragma unroll
        for (int i = 0; i < 16; ++i) { sca[i] = 0.f; scb[i] = 0.f; }
#pragma unroll 1
        for (int h = 0; h < 16; ++h) {
            const unsigned xh = fx ^ ((h & 1) << 3), hb = qbase + 256u * (h >> 1);
            f32x16 sa, sb;
#pragma unroll
            for (int i = 0; i < 16; ++i) { sa[i] = 0.f; sb[i] = 0.f; }
#pragma unroll
            for (int ks = 0; ks < 4; ++ks) { const bf16x8 qf = *(const LAS bf16x8*)(uintptr_t)(hb + 16u * (xh ^ (2 * ks)));
                sa = mfma32(ka[ks], qf, sa); sb = mfma32(kb[ks], qf, sb); }
            const float wv = wl[h];
#pragma unroll
            for (int i = 0; i < 16; ++i) { sca[i] = __builtin_fmaf(wv, fmaxf(sa[i], 0.f), sca[i]); scb[i] = __builtin_fmaf(wv, fmaxf(sb[i], 0.f), scb[i]); }
        }
        float* srow = Sc + (size_t)r * SEQ + 32 * kt + 4 * hh;
#pragma unroll
        for (int g = 0; g < 4; ++g) *(f32x4*)(srow + 8 * g) = (f32x4){sca[4 * g], sca[4 * g + 1], sca[4 * g + 2], sca[4 * g + 3]};
        if (kt + 8 <= qi) {
#pragma unroll
            for (int g = 0; g < 4; ++g) *(f32x4*)(srow + 256 + 8 * g) = (f32x4){scb[4 * g], scb[4 * g + 1], scb[4 * g + 2], scb[4 * g + 3]}; }
    }
    __syncthreads();
#pragma unroll 1
    for (int qq = 0; qq < 4; ++qq) {
        const int rr = 4 * w + qq, qpos = q0 + rr;
        const float* srow = Sc + (size_t)rr * SEQ + 32 * lane;
        float v[32];
        const bool have = (32 * lane <= qpos);
#pragma unroll
        for (int c = 0; c < 8; ++c) { f32x4 t = (f32x4){0.f, 0.f, 0.f, 0.f}; if (have) t = *(const f32x4*)(srow + 4 * c); v[4 * c] = t.x; v[4 * c + 1] = t.y; v[4 * c + 2] = t.z; v[4 * c + 3] = t.w; }
        const float ninf = -__builtin_inff();
#pragma unroll
        for (int e = 0; e < 32; ++e) if (32 * lane + e > qpos) v[e] = ninf;
        float Tf = -3.4028234663852886e38f;
        if (qpos + 1 > TOPK) {
            unsigned T = 0u;
#pragma unroll 1
            for (int bit = 31; bit >= 0; --bit) {
                const unsigned cand = T | (1u << bit); const float cf = cand_f(cand);
                int cnt = 0;
#pragma unroll
                for (int e = 0; e < 32; ++e) cnt += __builtin_popcountll(__ballot(v[e] >= cf));
                if (cnt >= TOPK) { T = cand; if (cnt == TOPK) break; }
            }
            Tf = cand_f(T);
        }
        unsigned word = 0u;
#pragma unroll
        for (int e = 0; e < 32; ++e) word |= (v[e] >= Tf) ? (1u << e) : 0u;
        F.Mask[(size_t)(b * SEQ + qpos) * 64 + lane] = word;
    }
    __syncthreads();
}
DI void p_indexer(Frame& F) {
    for (int it = blockIdx.x; it < 256; it += F.G) idx_unit(F, it & 3, it >> 2);
}
}


namespace mema {
using att::f32x16; using att::mfma32; using att::v4i16_t; using att::vtr; using att::pack8; using att::LOG2E; using att::off_b;
#define MEM_SB() __builtin_amdgcn_sched_barrier(0)
DI unsigned off_m(unsigned row, unsigned ch) { return 512u * row + 16u * (ch ^ (((row & 3) << 2) | ((row >> 2) & 3))); }
DI void mem_unit(Frame& F, int b, int hm, int qb) {
    const int tid = F.tid, lane = F.lane, w = F.wave, r = lane & 31, hh = lane >> 5;
    const int qrow = qb * 256 + 32 * w + r;
    const bf16* zrow = F.Z + (size_t)(b * SEQ + qrow) * ZLD;
    const unsigned ldsb = (unsigned)(uintptr_t)F.lds;
    const bf16* qp = zrow + ZC_MQ + hm * 256 + 8 * hh;
    const bf16* kvb = F.KVm + (size_t)(b * MEMT) * 2048 + hm * 256;
    f32x16 s[8];
    {
        const int srow = tid >> 5, sch = tid & 31;
        const bf16* kg = kvb + (size_t)srow * 2048 + sch * 8;
        unsigned lo[4];
#pragma unroll
        for (int i = 0; i < 4; ++i) lo[i] = off_m(srow + 16 * i, sch);
        unsigned ka8[8];
#pragma unroll
        for (int ks = 0; ks < 8; ++ks) ka8[ks] = off_m(r, 2 * ks + hh);
        u32x4 st0, st1, st2, st3;
#define MEM_LOADK(g) do { const bf16* p_ = kg + (size_t)(64 * (g)) * 2048; \
            st0 = *(const u32x4*)p_; st1 = *(const u32x4*)(p_ + (size_t)16 * 2048); st2 = *(const u32x4*)(p_ + (size_t)32 * 2048); st3 = *(const u32x4*)(p_ + (size_t)48 * 2048); } while (0)
#define MEM_WRITEK(g) do { LAS unsigned char* d_ = F.lds + ((g) & 1) * 32768; \
            *(LAS u32x4*)(d_ + lo[0]) = st0; *(LAS u32x4*)(d_ + lo[1]) = st1; *(LAS u32x4*)(d_ + lo[2]) = st2; *(LAS u32x4*)(d_ + lo[3]) = st3; } while (0)
        MEM_LOADK(0); MEM_WRITEK(0);
        __syncthreads();
#pragma unroll
        for (int st = 0; st < 4; ++st) {
            if (st < 3) MEM_LOADK(st + 1);
            const unsigned kb = ldsb + (st & 1) * 32768;
            f32x16 a0, a1;
#pragma unroll
            for (int i = 0; i < 16; ++i) { a0[i] = 0.f; a1[i] = 0.f; }
#pragma unroll
            for (int kq = 0; kq < 4; ++kq) {
                bf16x8 qf[4];
#pragma unroll
                for (int k4 = 0; k4 < 4; ++k4) qf[k4] = *(const bf16x8*)(qp + 16 * (4 * kq + k4));
#pragma unroll
                for (int k4 = 0; k4 < 4; ++k4) { const int ks = 4 * kq + k4;
                    const bf16x8 k0 = *(const LAS bf16x8*)(uintptr_t)(kb + (ks >> 3) * 256 + ka8[ks & 7]), k1 = *(const LAS bf16x8*)(uintptr_t)(kb + 16384 + (ks >> 3) * 256 + ka8[ks & 7]);
                    a0 = mfma32(k0, qf[k4], a0); a1 = mfma32(k1, qf[k4], a1); }
                MEM_SB();
            }
            s[2 * st] = a0; s[2 * st + 1] = a1;
            if (st < 3) MEM_WRITEK(st + 1);
            __syncthreads();
            MEM_SB();
        }
#undef MEM_LOADK
#undef MEM_WRITEK
    }
    float mx = -1e30f;
#pragma unroll
    for (int t = 0; t < 8; ++t)
#pragma unroll
        for (int i = 0; i < 16; ++i) mx = fmaxf(mx, s[t][i]);
    mx = fmaxf(mx, __shfl_xor(mx, 32));
    const float mL = mx * LOG2E;
    float l = 0.f;
    bf16x8 pf[8][2];
#pragma unroll
    for (int t = 0; t < 8; ++t) {
#pragma unroll
        for (int i = 0; i < 16; ++i) { const float p = __builtin_amdgcn_exp2f(__builtin_fmaf(s[t][i], LOG2E, -mL)); s[t][i] = p; l += p; }
        pf[t][0] = pack8(s[t], 0); pf[t][1] = pack8(s[t], 1);
    }
    l += __shfl_xor(l, 32);
    const float inv = 1.f / l;
    MEM_SB();
    {
        const int srow = tid >> 4, sch = tid & 15;
        const bf16* vg = kvb + 1024 + (size_t)srow * 2048 + sch * 8;
        const unsigned lo0 = off_b(srow, sch), lo1 = off_b(srow + 32, sch);
        unsigned vaddr[4][2];
        { const unsigned blk = (lane >> 4) & 1, q = (lane & 15) >> 2, p = lane & 3;
#pragma unroll
          for (int c = 0; c < 4; ++c)
#pragma unroll
            for (int t = 0; t < 2; ++t) vaddr[c][t] = off_b(8 * t + 4 * hh + q, 4 * c + 2 * blk + (p >> 1)) + 8 * (p & 1); }
        u32x4 v0, v1;
#define MEM_LOADV(g) do { const bf16* p_ = vg + ((g) >> 2) * 128 + (size_t)(64 * ((g) & 3)) * 2048; v0 = *(const u32x4*)p_; v1 = *(const u32x4*)(p_ + (size_t)32 * 2048); } while (0)
#define MEM_WRITEV(g) do { LAS unsigned char* d_ = F.lds + ((g) & 1) * 32768; *(LAS u32x4*)(d_ + lo0) = v0; *(LAS u32x4*)(d_ + lo1) = v1; } while (0)
        MEM_LOADV(0); MEM_WRITEV(0);
        __syncthreads();
        const bf16* grow = zrow + ZC_MG + hm * 256 + 4 * hh;
        bf16* yrow = F.Yb + (size_t)2 * MTOK * 1024 + (size_t)(b * SEQ + qrow) * 1024 + hm * 256 + 4 * hh;
        f32x16 o[4];
#pragma unroll
        for (int g = 0; g < 8; ++g) {
            const int st = g & 3;
            if (st == 0) {
#pragma unroll
                for (int c = 0; c < 4; ++c)
#pragma unroll
                    for (int i = 0; i < 16; ++i) o[c][i] = 0.f; }
            if (g < 7) MEM_LOADV(g + 1);
            const unsigned vb = ldsb + (g & 1) * 32768;
#pragma unroll
            for (int tt = 0; tt < 2; ++tt) {
#pragma unroll
                for (int c = 0; c < 4; ++c) {
                    const unsigned va = vb + tt * 8192;
                    const v4i16_t a00 = vtr(va + vaddr[c][0]), a01 = vtr(va + vaddr[c][1]), a10 = vtr(va + 4096 + vaddr[c][0]), a11 = vtr(va + 4096 + vaddr[c][1]);
                    const bf16x8 A0 = {a00[0], a00[1], a00[2], a00[3], a01[0], a01[1], a01[2], a01[3]};
                    const bf16x8 A1 = {a10[0], a10[1], a10[2], a10[3], a11[0], a11[1], a11[2], a11[3]};
                    o[c] = mfma32(A0, pf[2 * st + tt][0], o[c]); o[c] = mfma32(A1, pf[2 * st + tt][1], o[c]);
                }
            }
            if (g < 7) MEM_WRITEV(g + 1);
            __syncthreads();
            MEM_SB();
            if (st == 3) {
                const int dh = (g >> 2) * 128;
#pragma unroll
                for (int c = 0; c < 4; ++c)
#pragma unroll
                    for (int gg = 0; gg < 4; ++gg) { const int d0 = dh + 32 * c + 8 * gg; const u32x2 gw = *(const u32x2*)(grow + d0);
                        u32x2 ov; ov.x = pk2(silu_f(bflo(gw.x)) * o[c][4 * gg + 0] * inv, silu_f(bfhi(gw.x)) * o[c][4 * gg + 1] * inv);
                        ov.y = pk2(silu_f(bflo(gw.y)) * o[c][4 * gg + 2] * inv, silu_f(bfhi(gw.y)) * o[c][4 * gg + 3] * inv);
                        *(u32x2*)(yrow + d0) = ov; }
                MEM_SB();
            }
        }
#undef MEM_LOADV
#undef MEM_WRITEV
    }
}
#undef MEM_SB
DI void p_mem(Frame& F) {
    for (int u = blockIdx.x; u < 128; u += F.G) { const int xcd = u & 7, j = u >> 3, bhm = xcd * 2 + (j >> 3), qb = j & 7; mem_unit(F, bhm >> 2, bhm & 3, qb); }
}
}

constexpr int N_PHASES = 9;
struct Args { const float* in[12]; float* out; unsigned char* ws; int ph_lo, ph_hi; };
__global__ void __launch_bounds__(NTHR, 2) layer_fwd(Args args) {
    extern __shared__ __attribute__((aligned(16))) unsigned char lds[];
    Frame F;
    F.lds = (LAS unsigned char*)lds;
    F.tid = threadIdx.x; F.lane = F.tid & 63; F.wave = __builtin_amdgcn_readfirstlane(F.tid >> 6); F.G = gridDim.x;
    unsigned char* ws = args.ws;
    F.x = args.in[0]; F.mem = args.in[1]; F.pre_w = args.in[2]; F.w_in = args.in[3]; F.gn_w = args.in[4]; F.memn_w = args.in[5]; F.w_kv = args.in[6];
    F.w_up[0] = args.in[7]; F.w_up[1] = args.in[8]; F.w_up[2] = args.in[9]; F.w_o = args.in[10]; F.post_w = args.in[11]; F.out = args.out;
    F.WinT = (bf16*)(ws + WS_WINT); F.WkvT = (bf16*)(ws + WS_WKVT); F.WupT = (bf16*)(ws + WS_WUPT); F.WoT = (bf16*)(ws + WS_WOT);
    F.Hb = (bf16*)(ws + WS_HB); F.MemN = (bf16*)(ws + WS_MEMN); F.KVm = (bf16*)(ws + WS_KVM); F.Yb = (bf16*)(ws + WS_YB); F.Z = (bf16*)(ws + WS_Z);
    F.Merged = (bf16*)(ws + WS_MERGED); F.Mrg = (float*)(ws + WS_MRG); F.Sc = (float*)(ws + WS_WINT); F.Mask = (unsigned*)(ws + WS_MASK);
    volatile LAS unsigned* MISC = (volatile LAS unsigned*)(F.lds + MISC_OFF);
    if (F.tid < 32) MISC[F.tid] = 0u;
    __syncthreads();
    const int lo = args.ph_lo, hi = args.ph_hi;
    const bool one = (hi - lo) > 1;
    XcdBarrier bar; bar.bar = (unsigned*)(ws + WS_CTL) + CW_BAR; bar.x = 0; bar.st = nullptr;
    if (one) bar = xcd_barrier_post((unsigned*)(ws + WS_CTL) + CW_BAR, MISC + 8);
#define IN(k) (lo <= (k) && (k) < hi)
#define SEAM(k) do { if (IN(k) && IN((k) + 1)) xcd_barrier(bar); } while (0)
    if (IN(0)) { p0_prologue(F); } SEAM(0);
    if (IN(1)) {
        pg8::GemmG g{DM, DM, DM}; pg8::SchedP1 S{F.G, (int)blockIdx.x, (const char*)F.Hb, (const char*)F.WinT, (const char*)F.MemN, (const char*)F.WkvT};
        pg8::EpiZ E{F.Z, F.KVm};
        pg8::gemm_phase<pg8::EpiZ, pg8::SchedP1, true, true>(F.lds, g, S, E);
    } SEAM(1);
    if (IN(2)) { idx::p_indexer(F); } SEAM(2);
    if (IN(3)) { att::p_attn(F); } SEAM(3);
    if (IN(4)) { } SEAM(4);
    if (IN(5)) { mema::p_mem(F); } SEAM(5);
    if (IN(6)) {
        pg8::GemmG g{1024, 1024, 1024}; pg8::SchedTile S{F.G, (int)blockIdx.x, 3, (const char*)F.Yb, (const char*)F.WupT, (size_t)MTOK * 1024 * 2, (size_t)DM * 1024 * 2, 1024, 1024};
        pg8::EpiGate E{F.Z, F.Merged};
        pg8::gemm_phase<pg8::EpiGate, pg8::SchedTile, true, true>(F.lds, g, S, E);
    } SEAM(6);
    if (IN(7)) {
        pg8::GemmG g{DM, DM, DM}; pg8::SchedTile S{F.G, (int)blockIdx.x, 1, (const char*)F.Merged, (const char*)F.WoT, 0, 0, DM, DM};
        pg8::EpiOutF32 E{F.out};
        pg8::gemm_phase<pg8::EpiOutF32, pg8::SchedTile, true, true>(F.lds, g, S, E);
    } SEAM(7);
    if (IN(8)) { p_final(F); }
#undef IN
#undef SEAM
}

extern "C" void kernel_launch(void* const* d_in, const int* in_sizes, int n_in, void* d_out, int out_size, void* d_ws, size_t ws_size, hipStream_t stream) {
    static int grid = 0;
    if (grid == 0) {
        if (n_in != 12 || out_size != MTOK * DM || ws_size < WS_END) { fprintf(stderr, "kernel_launch: unexpected problem (n_in %d, out %d, ws %zu)\n", n_in, out_size, ws_size); grid = -1; return; }
        int dev = 0, cus = 0;
        if (hipGetDevice(&dev) != hipSuccess || hipDeviceGetAttribute(&cus, hipDeviceAttributeMultiprocessorCount, dev) != hipSuccess) { grid = -1; return; }
        if (hipFuncSetAttribute((const void*)layer_fwd, hipFuncAttributeMaxDynamicSharedMemorySize, LDS_BYTES) != hipSuccess) { fprintf(stderr, "kernel_launch: hipFuncSetAttribute failed\n"); grid = -1; return; }
        int per_cu = 0;
        if (hipOccupancyMaxActiveBlocksPerMultiprocessor(&per_cu, (const void*)layer_fwd, NTHR, LDS_BYTES) != hipSuccess || per_cu < 1) fprintf(stderr, "kernel_launch: occupancy query reports %d\n", per_cu);
        (void)hipGetLastError();
        grid = cus;
    }
    if (grid < 0) return;
    (void)hipMemsetAsync((char*)d_ws + WS_CTL, 0, CTL_ZERO_BYTES, stream);
    Args a{};
    for (int i = 0; i < 12; ++i) a.in[i] = (const float*)d_in[i];
    a.out = (float*)d_out; a.ws = (unsigned char*)d_ws;
#if MK_N_LAUNCHES == 1
    a.ph_lo = 0; a.ph_hi = N_PHASES;
    hipLaunchKernelGGL(layer_fwd, dim3(grid), dim3(NTHR), LDS_BYTES, stream, a);
#else
    for (int p = 0; p < N_PHASES; ++p) { a.ph_lo = p; a.ph_hi = p + 1; hipLaunchKernelGGL(layer_fwd, dim3(grid), dim3(NTHR), LDS_BYTES, stream, a); }
#endif
}
```

```cpp
#include <hip/hip_runtime.h>
#include <cstdio>
#include <cstdint>

#ifndef PROBE_REPEAT
#define PROBE_REPEAT -1
#endif
#ifndef MK_N_LAUNCHES
#define MK_N_LAUNCHES 1
#endif

#define GAS __attribute__((address_space(1)))
#define LAS __attribute__((address_space(3)))
typedef unsigned short bf16;
typedef short bf16x8 __attribute__((ext_vector_type(8)));
typedef float f32x4 __attribute__((ext_vector_type(4)));
typedef unsigned u32x4 __attribute__((ext_vector_type(4)));
typedef unsigned u32x2 __attribute__((ext_vector_type(2)));
typedef GAS unsigned gu32;
#define RLX_AGENT __ATOMIC_RELAXED, __HIP_MEMORY_SCOPE_AGENT
#define DI __device__ __forceinline__

constexpr int NB = 4, SEQ = 2048, DM = 2048, MTOK = NB * SEQ;
constexpr int NIN = 17488, ZLD = 17664;
constexpr int MEMT = 256, MROWS = NB * MEMT;
constexpr int ZC_RQ = 0, ZC_RK = 1024, ZC_RV = 2048, ZC_RG = 3072, ZC_AQ = 4096, ZC_AK = 5120, ZC_AV = 6144, ZC_AG = 7168,
              ZC_IQ = 8192, ZC_IK = 9216, ZC_IW = 9280, ZC_PAD = 9296, ZC_MQ = 9472, ZC_MG = 10496, ZC_GR = 11520, ZC_GD = 13568, ZC_GM = 15616;
constexpr int TOPK = 256;

constexpr size_t MiB = 1u << 20;
constexpr size_t WS_CTL = 0, CTL_ZERO_BYTES = 1 * MiB;
constexpr size_t WS_WINT = 1 * MiB;
constexpr size_t WS_MRG = 1 * MiB;
constexpr size_t WS_WKVT = 70 * MiB;
constexpr size_t WS_WUPT = 78 * MiB;
constexpr size_t WS_WOT = 90 * MiB;
constexpr size_t WS_HB = 98 * MiB;
constexpr size_t WS_MERGED = 98 * MiB;
constexpr size_t WS_MEMN = 130 * MiB;
constexpr size_t WS_KVM = 134 * MiB;
constexpr size_t WS_MASK = 138 * MiB;
constexpr size_t WS_YB = 141 * MiB;
constexpr size_t WS_Z = 189 * MiB;
constexpr size_t WS_END = 465 * MiB;
static_assert(WS_WINT + (size_t)ZLD * DM * 2 <= WS_WKVT && WS_Z + (size_t)MTOK * ZLD * 2 <= WS_END, "ws map");

constexpr int CW_BAR = 4096;

constexpr int NWAVES = 8, NTHR = 512;
constexpr int LDS_BYTES = 147456;
constexpr int MISC_OFF = 139264;

DI unsigned f2bf(float f) { unsigned u = __builtin_bit_cast(unsigned, f); return (u + 0x7fffu + ((u >> 16) & 1u)) >> 16; }
DI unsigned pk2(float lo, float hi) { return f2bf(lo) | (f2bf(hi) << 16); }
DI float bf2f(unsigned h) { return __builtin_bit_cast(float, h << 16); }
DI float bflo(unsigned w) { return __builtin_bit_cast(float, w << 16); }
DI float bfhi(unsigned w) { return __builtin_bit_cast(float, w & 0xffff0000u); }
DI float wave_sum(float v) {
#pragma unroll
    for (int o = 1; o < 64; o <<= 1) v += __shfl_xor(v, o);
    return v;
}
DI int wave_sum_i(int v) {
#pragma unroll
    for (int o = 1; o < 64; o <<= 1) v += __shfl_xor(v, o);
    return v;
}
DI float wave_max(float v) {
#pragma unroll
    for (int o = 1; o < 64; o <<= 1) v = fmaxf(v, __shfl_xor(v, o));
    return v;
}
DI float silu_f(float x) { return x / (1.f + __expf(-x)); }
DI float sigmoid_f(float x) { return 1.f / (1.f + __expf(-x)); }

#define XB_TMO      128
#define XB_XCNT(j)  (256  + 64 * (j))
#define XB_XSUB(j)  (1280 + 64 * (j))
#define XB_XGEN(j)  (2304 + 64 * (j))
#define XB_TOP      3328
#define XB_TOPGEN   3392
#define XCD_BAR_WORDS 3456
#define XB_SPIN_CAP (1u << 22)
DI unsigned xb_ld(unsigned* p)              { return __hip_atomic_load(p, __ATOMIC_RELAXED, __HIP_MEMORY_SCOPE_AGENT); }
DI unsigned xb_add(unsigned* p, unsigned v) { return __hip_atomic_fetch_add(p, v, __ATOMIC_RELAXED, __HIP_MEMORY_SCOPE_AGENT); }
DI unsigned xb_xcc_id() { return (unsigned)__builtin_amdgcn_s_getreg((3 << 11) | 20) & 0xFu; }
#define XB_SPIN(cond, bar) do { unsigned _sp = 0; while (cond) { __builtin_amdgcn_s_sleep(1); \
    if ((++_sp & 255u) == 0u) { if (xb_ld(&(bar)[XB_TMO])) break; if (_sp > XB_SPIN_CAP) { atomicAdd(&(bar)[XB_TMO], 1u); break; } } } } while (0)
struct XcdBarrier { unsigned* bar; unsigned x; volatile LAS unsigned* st; };
DI XcdBarrier xcd_barrier_post(unsigned* bar, volatile LAS unsigned* st) {
    XcdBarrier b; b.bar = bar; b.x = xb_xcc_id(); b.st = st;
    if (threadIdx.x == 0) (void)xb_add(&bar[XB_XCNT(b.x)], 1u);
    return b;
}
DI void xcd_barrier_complete(unsigned* bar, unsigned x, unsigned& nloc, unsigned& nx) {
    const unsigned G = gridDim.x * gridDim.y * gridDim.z;
    unsigned sum, cnt, mine, sp = 0u;
    for (;;) {
        sum = 0u; cnt = 0u; mine = 0u;
#pragma unroll
        for (unsigned j = 0; j < 16; ++j) { const unsigned c = xb_ld(&bar[XB_XCNT(j)]); sum += c; cnt += (c > 0u) ? 1u : 0u; mine = (j == x) ? c : mine; }
        if (sum == G) break;
        __builtin_amdgcn_s_sleep(1);
        if ((++sp & 255u) == 0u) { if (xb_ld(&bar[XB_TMO])) break; if (sp > XB_SPIN_CAP) { atomicAdd(&bar[XB_TMO], 1u); break; } }
    }
    nloc = mine > 0u ? mine : 1u; nx = cnt > 0u ? cnt : 1u;
}
DI void xcd_barrier(const XcdBarrier& b) {
    asm volatile("s_waitcnt vmcnt(0)" ::: "memory");
    __syncthreads();
    if (threadIdx.x == 0) {
        unsigned* bar = b.bar;
        __builtin_amdgcn_s_waitcnt(0);
        unsigned nloc = b.st[0], nx = b.st[1];
        if (nloc == 0u) { xcd_barrier_complete(bar, b.x, nloc, nx); b.st[0] = nloc; b.st[1] = nx; }
        const unsigned old = xb_add(&bar[XB_XSUB(b.x)], 1u);
        const unsigned gen = old / nloc;
        if (old + 1u == (gen + 1u) * nloc) {
            __builtin_amdgcn_fence(__ATOMIC_RELEASE, "agent");
            asm volatile("s_waitcnt vmcnt(0)" ::: "memory");
            const unsigned og = xb_add(&bar[XB_TOP], 1u);
            const unsigned tg = og / nx;
            if (og + 1u == (tg + 1u) * nx) xb_add(&bar[XB_TOPGEN], 1u);
            else XB_SPIN(xb_ld(&bar[XB_TOPGEN]) == tg, bar);
            __builtin_amdgcn_fence(__ATOMIC_ACQUIRE, "agent");
            xb_add(&bar[XB_XGEN(b.x)], 1u);
            asm volatile("s_waitcnt vmcnt(0)" ::: "memory");
        } else {
            XB_SPIN(xb_ld(&bar[XB_XGEN(b.x)]) == gen, bar);
            __builtin_amdgcn_fence(__ATOMIC_ACQUIRE, "agent");
            asm volatile("s_waitcnt vmcnt(0)" ::: "memory");
        }
    }
    __syncthreads();
}

struct Frame {
    LAS unsigned char* lds;
    int tid, lane, wave, G;
    const float *x, *mem, *pre_w, *w_in, *gn_w, *memn_w, *w_kv, *w_up[3], *w_o, *post_w;
    float* out;
    bf16 *WinT, *WkvT, *WupT, *WoT, *Hb, *MemN, *KVm, *Yb, *Z, *Merged;
    float* Mrg; float* Sc;
    unsigned* Mask;
};

template <int KIND> DI int src_col(int n) { if (KIND == 0) return n < ZC_PAD ? n : (n < ZC_MQ ? -1 : n - (ZC_MQ - ZC_PAD)); return n; }
template <int KIND> DI float src_scale(int n) {
    if (KIND == 0) {
        if (n >= ZC_RK && n < ZC_RV) return 0.08838834764831845f;
        if (n >= ZC_AQ && n < ZC_AK) return 0.08838834764831845f * 1.4426950408889634f;
        if (n >= ZC_IQ && n < ZC_IK) return 0.125f;
        if (n >= ZC_IW && n < ZC_PAD) return 0.125f;
        if (n >= ZC_MQ && n < ZC_MG) return 0.0625f;
    }
    return 1.f;
}
template <int KIND> DI void p0_transpose_item(const float* W, int K, int Nsrc, int Ndst, bf16* WT, LAS float* scr, int item, int lane) {
    const int nblk = Ndst / 64, kb = item / nblk, nb = item % nblk, k0 = 64 * kb, n0 = 64 * nb;
    const int sc = src_col<KIND>(n0 + lane); const float s = src_scale<KIND>(n0 + lane);
    const float* src = W + (size_t)k0 * Nsrc + (sc < 0 ? 0 : sc);
#pragma unroll 8
    for (int i = 0; i < 64; ++i) { const float v = src[(size_t)i * Nsrc]; scr[i * 65 + lane] = sc < 0 ? 0.f : v * s; }
    asm volatile("s_waitcnt lgkmcnt(0)" ::: "memory");
    const int c = lane & 7;
#pragma unroll
    for (int j = 0; j < 8; ++j) { const int n = (lane >> 3) + 8 * j; const LAS float* p = scr + (8 * c) * 65 + n;
        u32x4 o; o.x = pk2(p[0 * 65], p[1 * 65]); o.y = pk2(p[2 * 65], p[3 * 65]); o.z = pk2(p[4 * 65], p[5 * 65]); o.w = pk2(p[6 * 65], p[7 * 65]);
        *(u32x4*)(WT + (size_t)(n0 + n) * K + k0 + 8 * c) = o; }
    asm volatile("s_waitcnt lgkmcnt(0)" ::: "memory");
}
DI void rms_row_to_bf16(const float* xrow, const float* w, bf16* orow, float eps, int lane) {
    const f32x4* xr = (const f32x4*)xrow + lane; const f32x4* wr = (const f32x4*)w + lane;
    f32x4 v[8]; float s = 0.f;
#pragma unroll
    for (int j = 0; j < 8; ++j) { v[j] = xr[64 * j]; s += (v[j].x * v[j].x + v[j].y * v[j].y) + (v[j].z * v[j].z + v[j].w * v[j].w); }
    const float r = 1.0f / sqrtf(wave_sum(s) * (1.f / DM) + eps);
    u32x2* o8 = (u32x2*)orow + lane;
#pragma unroll
    for (int j = 0; j < 8; ++j) { const f32x4 ww = wr[64 * j]; u32x2 o; o.x = pk2(v[j].x * r * ww.x, v[j].y * r * ww.y); o.y = pk2(v[j].z * r * ww.z, v[j].w * r * ww.w); o8[64 * j] = o; }
}
DI void p0_prologue(Frame& F) {
    LAS float* scr = (LAS float*)(F.lds + F.wave * 16640);
    const int gw = blockIdx.x * NWAVES + F.wave, NGW = F.G * NWAVES;
    constexpr int I_IN = (DM / 64) * (ZLD / 64), I_KV = (DM / 64) * (2048 / 64), I_UP = (1024 / 64) * (DM / 64), I_O = (DM / 64) * (DM / 64);
    constexpr int NITEMS = I_IN + I_KV + 3 * I_UP + I_O;
    for (int it = gw; it < NITEMS; it += NGW) {
        int r = it;
        if (r < I_IN) { p0_transpose_item<0>(F.w_in, DM, NIN, ZLD, F.WinT, scr, r, F.lane); continue; } r -= I_IN;
        if (r < I_KV) { p0_transpose_item<1>(F.w_kv, DM, 2048, 2048, F.WkvT, scr, r, F.lane); continue; } r -= I_KV;
        if (r < I_UP) { p0_transpose_item<1>(F.w_up[0], 1024, DM, DM, F.WupT, scr, r, F.lane); continue; } r -= I_UP;
        if (r < I_UP) { p0_transpose_item<1>(F.w_up[1], 1024, DM, DM, F.WupT + (size_t)DM * 1024, scr, r, F.lane); continue; } r -= I_UP;
        if (r < I_UP) { p0_transpose_item<1>(F.w_up[2], 1024, DM, DM, F.WupT + (size_t)2 * DM * 1024, scr, r, F.lane); continue; } r -= I_UP;
        p0_transpose_item<1>(F.w_o, DM, DM, DM, F.WoT, scr, r, F.lane);
    }
    for (int m = gw; m < MTOK + MROWS; m += NGW) {
        if (m < MTOK) rms_row_to_bf16(F.x + (size_t)m * DM, F.pre_w, F.Hb + (size_t)m * DM, 1e-6f, F.lane);
        else rms_row_to_bf16(F.mem + (size_t)(m - MTOK) * DM, F.memn_w, F.MemN + (size_t)(m - MTOK) * DM, 1e-6f, F.lane);
    }
}


namespace pg8 {
#define PG8_LAS __attribute__((address_space(3)))
constexpr int BM = 256, BK = 64, HALF = 128, HTB = HALF * BK * 2, STAGE_BYTES = 8 * HTB, NXCD = 8, WGM = 8;
DI int lds_byte(int r, int c) { const int st = (r >> 4) * 2 + (c >> 5), rr = r & 15, cc = c & 31, ob = rr * 64 + cc * 2; return st * 1024 + (ob ^ (((ob >> 9) & 1) << 5)); }
DI void stage_rc(int b, int& R, int& C) { const int st = b / 1024, sb = b % 1024, swz = sb ^ (((sb >> 9) & 1) << 5); R = (st >> 1) * 16 + swz / 64; C = (st & 1) * 32 + (swz % 64) / 2; }
DI int perm32(int rho) { const int n = rho >> 4, i = rho & 15; return 8 * (i >> 2) + 4 * n + (i & 3); }
struct Unit { int pm, pn, w; };
struct GemmG { int lda, ldb, K; };
DI unsigned cvt_pk_bf16(float lo, float hi) { unsigned r; asm volatile("v_cvt_pk_bf16_f32 %0, %1, %2" : "=v"(r) : "v"(lo), "v"(hi)); return r; }
template <class Epi, class Sched, bool ALIGN_EPI = false, bool SP2 = false>
__device__ __forceinline__ void gemm_phase(PG8_LAS unsigned char* lds, const GemmG g, const Sched& S, const Epi& E) {
    const int tid = threadIdx.x, wid = __builtin_amdgcn_readfirstlane(tid >> 6), lane = tid & 63, wr = wid >> 2, wc = wid & 3, fr = lane & 15, fq = lane >> 4;
    const int K = g.K, nt = K / BK;
    unsigned voffA[2], voffB[2];
#pragma unroll
    for (int i = 0; i < 2; ++i) { int R, C; stage_rc(tid * 16 + i * 8192, R, C); const int Rb = Epi::PERM ? ((R & ~31) + perm32(R & 31)) : R;
        voffA[i] = (unsigned)(R * g.lda + C) * 2u; voffB[i] = (unsigned)(Rb * g.ldb + C) * 2u; }
    const size_t kstep = (size_t)(BK * 2);
    const size_t hstepA = (size_t)HALF * g.lda * 2, hstepB = (size_t)HALF * g.ldb * 2;
    const unsigned ldsw = (unsigned)wid * 1024u;
    const int aoff = lds_byte(wr * 64 + fr, fq * 8), boff = lds_byte(wc * 32 + fr, fq * 8);
#define PG8_SA(b, h) (((b) * 2 + (h)) * HTB)
#define PG8_SB(b, h) ((4 + (b) * 2 + (h)) * HTB)
#define PG8_STAGE(bufoff, gbase, voff) do { _Pragma("unroll") for (int _i = 0; _i < 2; ++_i) \
        __builtin_amdgcn_global_load_lds((const unsigned*)((const char*)(gbase) + (voff)[_i]), (PG8_LAS unsigned*)(lds + (bufoff) + ldsw + _i * 8192), 16, 0, 0); } while (0)
#define PG8_LDA(dst, b, h) do { _Pragma("unroll") for (int m = 0; m < 4; ++m) _Pragma("unroll") for (int k = 0; k < 2; ++k) dst[m][k] = *(const PG8_LAS bf16x8*)(lds + PG8_SA(b, h) + aoff + m * 2048 + k * 1024); } while (0)
#define PG8_LDB(dst, b, h) do { _Pragma("unroll") for (int n = 0; n < 2; ++n) _Pragma("unroll") for (int k = 0; k < 2; ++k) dst[n][k] = *(const PG8_LAS bf16x8*)(lds + PG8_SB(b, h) + boff + n * 2048 + k * 1024); } while (0)
#define PG8_MMA(ai, bj, At, Bt) do { __builtin_amdgcn_s_setprio(1); _Pragma("unroll") for (int m = 0; m < 4; ++m) _Pragma("unroll") for (int n = 0; n < 2; ++n) _Pragma("unroll") for (int k = 0; k < 2; ++k) \
        acc[ai][bj][m][n] = __builtin_amdgcn_mfma_f32_16x16x32_bf16(Bt[n][k], At[m][k], acc[ai][bj][m][n], 0, 0, 0); __builtin_amdgcn_s_setprio(0); } while (0)
#define PG8_WAIT_V(n) asm volatile("s_waitcnt vmcnt(" #n ")" ::: "memory")
#define PG8_WAIT_L(n) asm volatile("s_waitcnt lgkmcnt(" #n ")" ::: "memory")
#define PG8_BAR __builtin_amdgcn_s_barrier()
#define PG8_SCHED __builtin_amdgcn_sched_barrier(0)
    Unit cur, nxt; int ui = 0;
    if (!S.next(0, cur)) return;
    f32x4 acc[2][2][4][2];
#pragma unroll
    for (int a = 0; a < 2; ++a)
#pragma unroll
        for (int b = 0; b < 2; ++b)
#pragma unroll
            for (int m = 0; m < 4; ++m)
#pragma unroll
                for (int n = 0; n < 2; ++n) acc[a][b][m][n] = (f32x4){0.f, 0.f, 0.f, 0.f};
    bf16x8 At[4][2], B0[2][2], B1[2][2];
    const char* cA = S.a_ptr(cur); const char* cB = S.b_ptr(cur);
    S.a_ready(cur);
    if constexpr (SP2) {
        PG8_STAGE(PG8_SB(0, 0), cB, voffB); PG8_STAGE(PG8_SB(0, 1), cB + hstepB, voffB); PG8_STAGE(PG8_SA(0, 0), cA, voffA); PG8_STAGE(PG8_SA(0, 1), cA + hstepA, voffA);
        if (wr == 1) PG8_BAR;
        PG8_WAIT_V(2); PG8_BAR;
        PG8_STAGE(PG8_SB(1, 0), cB + kstep, voffB); PG8_STAGE(PG8_SA(1, 0), cA + kstep, voffA); PG8_STAGE(PG8_SB(1, 1), cB + hstepB + kstep, voffB);
        PG8_WAIT_V(6); PG8_BAR;
    } else {
        PG8_STAGE(PG8_SB(0, 0), cB, voffB); PG8_STAGE(PG8_SA(0, 0), cA, voffA); PG8_STAGE(PG8_SB(0, 1), cB + hstepB, voffB); PG8_STAGE(PG8_SA(0, 1), cA + hstepA, voffA);
        if (wr == 1) PG8_BAR;
        PG8_WAIT_V(4); PG8_BAR;
        PG8_STAGE(PG8_SB(1, 0), cB + kstep, voffB); PG8_STAGE(PG8_SA(1, 0), cA + kstep, voffA); PG8_STAGE(PG8_SB(1, 1), cB + hstepB + kstep, voffB);
        PG8_WAIT_V(6); PG8_BAR;
    }
    for (;;) {
        const bool has_next = S.next(ui + 1, nxt);
        const char* nA = has_next ? S.a_ptr(nxt) : cA; const char* nB = has_next ? S.b_ptr(nxt) : cB;
        for (int t = 0; t < nt; t += 2) {
            const bool last = (t == nt - 2);
            const char* a1 = cA + (size_t)(t + 1) * kstep;
            const char* a2 = last ? nA : cA + (size_t)(t + 2) * kstep; const char* b2 = last ? nB : cB + (size_t)(t + 2) * kstep;
            const char* a3 = a2 + kstep; const char* b3 = b2 + kstep;
            if (last && has_next) S.a_ready(nxt);
            if constexpr (SP2) {
            PG8_LDB(B0, 0, 0); PG8_LDB(B1, 0, 1); PG8_SCHED; PG8_LDA(At, 0, 0); PG8_STAGE(PG8_SA(1, 1), a1 + hstepA, voffA);
            PG8_WAIT_V(8); PG8_WAIT_L(0); PG8_BAR; PG8_MMA(0, 0, At, B0); PG8_MMA(0, 1, At, B1); PG8_BAR; PG8_SCHED;
            PG8_LDA(At, 0, 1); PG8_STAGE(PG8_SB(0, 0), b2, voffB); PG8_STAGE(PG8_SB(0, 1), b2 + hstepB, voffB); PG8_STAGE(PG8_SA(0, 0), a2, voffA);
            PG8_WAIT_V(8); PG8_WAIT_L(0); PG8_BAR; PG8_MMA(1, 0, At, B0); PG8_MMA(1, 1, At, B1); PG8_BAR; PG8_SCHED;
            PG8_LDB(B0, 1, 0); PG8_LDB(B1, 1, 1); PG8_SCHED; PG8_LDA(At, 1, 0); PG8_STAGE(PG8_SA(0, 1), a2 + hstepA, voffA);
            PG8_WAIT_V(8); PG8_WAIT_L(0); PG8_BAR; PG8_MMA(0, 0, At, B0); PG8_MMA(0, 1, At, B1); PG8_BAR; PG8_SCHED;
            PG8_LDA(At, 1, 1); PG8_STAGE(PG8_SB(1, 0), b3, voffB); PG8_STAGE(PG8_SB(1, 1), b3 + hstepB, voffB); PG8_STAGE(PG8_SA(1, 0), a3, voffA);
            PG8_WAIT_V(8); PG8_WAIT_L(0); PG8_BAR; PG8_MMA(1, 0, At, B0); PG8_MMA(1, 1, At, B1); PG8_BAR; PG8_SCHED;
            } else {
            PG8_LDB(B0, 0, 0); PG8_SCHED; PG8_LDA(At, 0, 0); PG8_STAGE(PG8_SA(1, 1), a1 + hstepA, voffA);
            PG8_WAIT_L(8); PG8_BAR; PG8_WAIT_L(0); PG8_MMA(0, 0, At, B0); PG8_BAR; PG8_SCHED;
            PG8_LDB(B1, 0, 1); PG8_STAGE(PG8_SB(0, 0), b2, voffB);
            PG8_BAR; PG8_WAIT_L(0); PG8_MMA(0, 1, At, B1); PG8_BAR;
            PG8_LDA(At, 0, 1); PG8_STAGE(PG8_SA(0, 0), a2, voffA);
            PG8_BAR; PG8_WAIT_L(0); PG8_MMA(1, 0, At, B0); PG8_BAR; PG8_SCHED;
            PG8_STAGE(PG8_SB(0, 1), b2 + hstepB, voffB);
            PG8_WAIT_V(6); PG8_BAR; PG8_MMA(1, 1, At, B1); PG8_BAR;
            PG8_LDB(B0, 1, 0); PG8_SCHED; PG8_LDA(At, 1, 0); PG8_STAGE(PG8_SA(0, 1), a2 + hstepA, voffA);
            PG8_WAIT_L(8); PG8_BAR; PG8_WAIT_L(0); PG8_MMA(0, 0, At, B0); PG8_BAR; PG8_SCHED;
            PG8_LDB(B1, 1, 1); PG8_STAGE(PG8_SB(1, 0), b3, voffB);
            PG8_BAR; PG8_WAIT_L(0); PG8_MMA(0, 1, At, B1); PG8_BAR;
            PG8_LDA(At, 1, 1); PG8_STAGE(PG8_SA(1, 0), a3, voffA);
            PG8_BAR; PG8_WAIT_L(0); PG8_MMA(1, 0, At, B0); PG8_BAR; PG8_SCHED;
            PG8_STAGE(PG8_SB(1, 1), b3 + hstepB, voffB);
            PG8_WAIT_V(6); PG8_BAR; PG8_MMA(1, 1, At, B1); PG8_BAR;
            }
        }
        if constexpr (ALIGN_EPI) { if (wr == 0) PG8_BAR; }
        if constexpr (!Epi::AFTER_DRAIN) { E(acc, cur, wr, wc, fr, fq); S.done(cur); }
        if (!has_next) break;
        if (!Epi::keep_acc(cur))
#pragma unroll
        for (int a = 0; a < 2; ++a)
#pragma unroll
            for (int b = 0; b < 2; ++b)
#pragma unroll
                for (int m = 0; m < 4; ++m)
#pragma unroll
                    for (int n = 0; n < 2; ++n) acc[a][b][m][n] = (f32x4){0.f, 0.f, 0.f, 0.f};
        cur = nxt; cA = nA; cB = nB; ++ui;
        if constexpr (ALIGN_EPI) { if (wr == 1) PG8_BAR; }
    }
    PG8_WAIT_V(0);
    if constexpr (!ALIGN_EPI) { if (wr == 0) PG8_BAR; }
    PG8_BAR;
    if constexpr (Epi::AFTER_DRAIN) { E.fused(acc, cur, wr, wc, fr, fq, lds, wid, lane); S.done(cur); }
#undef PG8_SA
#undef PG8_SB
#undef PG8_STAGE
#undef PG8_LDA
#undef PG8_LDB
#undef PG8_MMA
#undef PG8_WAIT_V
#undef PG8_WAIT_L
#undef PG8_BAR
#undef PG8_SCHED
}

}


namespace pg8 {
struct EpiZ {
    static constexpr bool PERM = true, AFTER_DRAIN = false; static DI bool keep_acc(const Unit&) { return false; }
    bf16* Z; bf16* KV;
    DI void operator()(f32x4 (&acc)[2][2][4][2], const Unit& u, int wr, int wc, int fr, int fq) const {
        bf16* base = u.w ? KV : Z; const int ld = u.w ? 2048 : ZLD;
        const int row0 = u.pm * BM + wr * 64 + fr, col0 = u.pn * BM + wc * 32 + 8 * fq;
        const bool ret = (u.w == 0) && (u.pn < 8);
        float lg2[2] = {0.f, 0.f};
        if (ret) {
#pragma unroll
            for (int bj = 0; bj < 2; ++bj) { const int hd = 2 * (u.pn & 3) + bj; lg2[bj] = log2f(1.f - exp2f(-5.f - (float)hd)) * (u.pn < 4 ? 1.f : -1.f); } }
#pragma unroll
        for (int ai = 0; ai < 2; ++ai)
#pragma unroll
            for (int m = 0; m < 4; ++m) { const int row = row0 + ai * HALF + m * 16; bf16* rowp = base + (size_t)row * ld + col0;
#pragma unroll
                for (int bj = 0; bj < 2; ++bj) { f32x4 v0 = acc[ai][bj][m][0], v1 = acc[ai][bj][m][1];
                    if (ret) { const float sc = __builtin_amdgcn_exp2f((float)(row & (SEQ - 1)) * lg2[bj]); v0 = v0 * sc; v1 = v1 * sc; }
                    u32x4 w; w.x = cvt_pk_bf16(v0[0], v0[1]); w.y = cvt_pk_bf16(v0[2], v0[3]); w.z = cvt_pk_bf16(v1[0], v1[1]); w.w = cvt_pk_bf16(v1[2], v1[3]);
                    *(u32x4*)(rowp + bj * HALF) = w; } }
    }
};
DI float expneg_c(float g) { return __expf(-fminf(fmaxf(g, -60.f), 60.f)); }
struct EpiGate {
    static constexpr bool PERM = true, AFTER_DRAIN = false; static DI bool keep_acc(const Unit& u) { return u.w < 2; }
    const bf16* Z; bf16* Out;
    DI void operator()(f32x4 (&acc)[2][2][4][2], const Unit& u, int wr, int wc, int fr, int fq) const {
        const int b = u.w;
        const int row0 = u.pm * BM + wr * 64 + fr, col0 = u.pn * BM + wc * 32 + 8 * fq;
        const bf16* ga = Z + ZC_GR + 2048 * b; const bf16* gb = ga + 2048;
#pragma unroll
        for (int ai = 0; ai < 2; ++ai)
#pragma unroll
            for (int m = 0; m < 4; ++m) { const size_t roff = (size_t)(row0 + ai * HALF + m * 16);
#pragma unroll
                for (int bj = 0; bj < 2; ++bj) { const int col = col0 + bj * HALF;
                    const u32x4 a = *(const u32x4*)(ga + roff * ZLD + col);
                    float ea[8] = {expneg_c(bflo(a.x)), expneg_c(bfhi(a.x)), expneg_c(bflo(a.y)), expneg_c(bfhi(a.y)), expneg_c(bflo(a.z)), expneg_c(bfhi(a.z)), expneg_c(bflo(a.w)), expneg_c(bfhi(a.w))};
                    float f[8];
                    if (b < 2) { const u32x4 c = *(const u32x4*)(gb + roff * ZLD + col);
                        const float eb[8] = {expneg_c(bflo(c.x)), expneg_c(bfhi(c.x)), expneg_c(bflo(c.y)), expneg_c(bfhi(c.y)), expneg_c(bflo(c.z)), expneg_c(bfhi(c.z)), expneg_c(bflo(c.w)), expneg_c(bfhi(c.w))};
#pragma unroll
                        for (int e = 0; e < 8; ++e) f[e] = (1.f + eb[e]) * __builtin_amdgcn_rcpf(1.f + ea[e]);
                    } else {
#pragma unroll
                        for (int e = 0; e < 8; ++e) f[e] = __builtin_amdgcn_rcpf(1.f + ea[e]);
                    }
                    f32x4 v0 = acc[ai][bj][m][0], v1 = acc[ai][bj][m][1];
                    v0[0] *= f[0]; v0[1] *= f[1]; v0[2] *= f[2]; v0[3] *= f[3]; v1[0] *= f[4]; v1[1] *= f[5]; v1[2] *= f[6]; v1[3] *= f[7];
                    if (b < 2) { acc[ai][bj][m][0] = v0; acc[ai][bj][m][1] = v1; }
                    else { u32x4 w; w.x = cvt_pk_bf16(v0[0], v0[1]); w.y = cvt_pk_bf16(v0[2], v0[3]); w.z = cvt_pk_bf16(v1[0], v1[1]); w.w = cvt_pk_bf16(v1[2], v1[3]);
                        *(u32x4*)(Out + roff * DM + col) = w; } } }
    }
};
struct EpiOutF32 {
    static constexpr bool PERM = true, AFTER_DRAIN = false; static DI bool keep_acc(const Unit&) { return false; }
    float* O;
    DI void operator()(f32x4 (&acc)[2][2][4][2], const Unit& u, int wr, int wc, int fr, int fq) const {
        const int row0 = u.pm * BM + wr * 64 + fr, col0 = u.pn * BM + wc * 32 + 8 * fq;
#pragma unroll
        for (int ai = 0; ai < 2; ++ai)
#pragma unroll
            for (int m = 0; m < 4; ++m) { float* rowp = O + (size_t)(row0 + ai * HALF + m * 16) * DM + col0;
#pragma unroll
                for (int bj = 0; bj < 2; ++bj) { *(f32x4*)(rowp + bj * HALF) = acc[ai][bj][m][0]; *(f32x4*)(rowp + bj * HALF + 4) = acc[ai][bj][m][1]; } }
    }
};
struct SchedP1 {
    int G, c; const char *A0, *B0, *A1, *B1;
    static constexpr int nM = MTOK / BM, nN = ZLD / BM, nwg = nM * nN, NKV = (MROWS / BM) * (2048 / BM);
    DI bool next(int i, Unit& u) const {
        const long L = (long)i * G + c; if (L >= nwg + NKV) return false;
        const int k = (int)L - nwg; const bool kv = k >= 0;
        int wgid = kv ? 0 : (int)L; { const int q = nwg / NXCD, r = nwg % NXCD, xcd = wgid % NXCD, off = wgid / NXCD; wgid = (xcd < r ? xcd * (q + 1) : r * (q + 1) + (xcd - r) * q) + off; }
        const int nig = WGM * nN, gid = wgid / nig, fm = gid * WGM, gsz = (nM - fm) < WGM ? (nM - fm) : WGM;
        const int pm0 = fm + ((wgid % nig) % gsz), pn0 = (wgid % nig) / gsz;
        Unit r_; r_.pm = kv ? (k & 3) : pm0; r_.pn = kv ? (k >> 2) : pn0; r_.w = kv ? 1 : 0; u = r_; return true;
    }
    DI const char* a_ptr(const Unit& u) const { return (u.w ? A1 : A0) + (size_t)u.pm * ((size_t)BM * DM * 2); }
    DI const char* b_ptr(const Unit& u) const { return (u.w ? B1 : B0) + (size_t)u.pn * ((size_t)BM * DM * 2); }
    DI void a_ready(const Unit&) const {}
    DI void done(const Unit&) const {}
};
struct SchedTile {
    int G, c, nb; const char *A, *B; size_t sAb, sBb; int lda, ldb;
    DI bool next(int i, Unit& u) const {
        const int T = (i / nb) * G + c; if (T >= 256) return false;
        const int xcd = T & 7, j = T >> 3; Unit r_; r_.w = i % nb; r_.pm = xcd * 4 + (j & 3); r_.pn = j >> 2; u = r_; return true;
    }
    DI const char* a_ptr(const Unit& u) const { return A + (size_t)u.w * sAb + (size_t)u.pm * ((size_t)BM * lda * 2); }
    DI const char* b_ptr(const Unit& u) const { return B + (size_t)u.w * sBb + (size_t)u.pn * ((size_t)BM * ldb * 2); }
    DI void a_ready(const Unit&) const {}
    DI void done(const Unit&) const {}
};
}

template <class Epi> DI void simple_gemm(Frame& F, const bf16* A, int lda, const bf16* Bt, int ldb, int M, int N, int K, const Epi& E) {
    const int wr = F.wave >> 2, wc = F.wave & 3, fr = F.lane & 15, fq = F.lane >> 4;
    const int ntn = N / 128, ntiles = (M / 128) * ntn;
    for (int t = blockIdx.x; t < ntiles; t += F.G) {
        const int tm = t / ntn, tn = t % ntn;
        const int row0 = tm * 128 + wr * 64, col0 = tn * 128 + wc * 32;
        f32x4 acc[4][2];
#pragma unroll
        for (int m = 0; m < 4; ++m)
#pragma unroll
            for (int n = 0; n < 2; ++n) acc[m][n] = (f32x4){0.f, 0.f, 0.f, 0.f};
        const bf16* ap = A + (size_t)(row0 + fr) * lda + 8 * fq;
        const bf16* bp = Bt + (size_t)(col0 + fr) * ldb + 8 * fq;
        for (int k0 = 0; k0 < K; k0 += 32) {
            bf16x8 a[4], b[2];
#pragma unroll
            for (int m = 0; m < 4; ++m) a[m] = *(const bf16x8*)(ap + (size_t)(16 * m) * lda + k0);
#pragma unroll
            for (int n = 0; n < 2; ++n) b[n] = *(const bf16x8*)(bp + (size_t)(16 * n) * ldb + k0);
#pragma unroll
            for (int m = 0; m < 4; ++m)
#pragma unroll
                for (int n = 0; n < 2; ++n) acc[m][n] = __builtin_amdgcn_mfma_f32_16x16x32_bf16(b[n], a[m], acc[m][n], 0, 0, 0);
        }
#pragma unroll
        for (int m = 0; m < 4; ++m)
#pragma unroll
            for (int n = 0; n < 2; ++n) E(row0 + 16 * m + fr, col0 + 16 * n + 4 * fq, acc[m][n]);
    }
}
struct EpiBf16Store { bf16* O; int ld;
    DI void operator()(int row, int col, f32x4 v) const { u32x2 o; o.x = pk2(v.x, v.y); o.y = pk2(v.z, v.w); *(u32x2*)(O + (size_t)row * ld + col) = o; } };
template <int MODE> struct EpiGate { const bf16* G; float* Mrg; bf16* Out;
    DI void operator()(int row, int col, f32x4 v) const {
        const u32x2 g = *(const u32x2*)(G + (size_t)row * ZLD + col);
        f32x4 r; r.x = sigmoid_f(bflo(g.x)) * v.x; r.y = sigmoid_f(bfhi(g.x)) * v.y; r.z = sigmoid_f(bflo(g.y)) * v.z; r.w = sigmoid_f(bfhi(g.y)) * v.w;
        float* mp = Mrg + (size_t)row * DM + col;
        if (MODE >= 1) r = r + *(const f32x4*)mp;
        if (MODE <= 1) *(f32x4*)mp = r;
        else { u32x2 o; o.x = pk2(r.x, r.y); o.y = pk2(r.z, r.w); *(u32x2*)(Out + (size_t)row * DM + col) = o; }
    } };
struct EpiF32Store { float* O; int ld;
    DI void operator()(int row, int col, f32x4 v) const { *(f32x4*)(O + (size_t)row * ld + col) = v; } };

DI unsigned okey(float f) { const unsigned u = __builtin_bit_cast(unsigned, f); return (u & 0x80000000u) ? ~u : (u | 0x80000000u); }

DI void p_indexer_naive(Frame& F) {
    LAS float* qf = (LAS float*)F.lds;
    LAS float* wf = qf + 1024;
    LAS float* sc = qf + 1024 + 64;
    LAS int* red = (LAS int*)(sc + 2048);
    const int tid = F.tid;
    for (int t = blockIdx.x; t < MTOK; t += F.G) {
        const int b = t / SEQ, i = t % SEQ;
        const bf16* zrow = F.Z + (size_t)t * ZLD;
        for (int e = tid; e < 1024; e += NTHR) qf[e] = bf2f(zrow[ZC_IQ + e]);
        if (tid < 16) wf[tid] = bf2f(zrow[ZC_IW + tid]);
        __syncthreads();
        for (int s = tid; s <= i; s += NTHR) {
            const u32x4* kp = (const u32x4*)(F.Z + (size_t)(b * SEQ + s) * ZLD + ZC_IK);
            float kf[64];
#pragma unroll
            for (int c = 0; c < 8; ++c) { const u32x4 w = kp[c];
                kf[8 * c + 0] = bflo(w.x); kf[8 * c + 1] = bfhi(w.x); kf[8 * c + 2] = bflo(w.y); kf[8 * c + 3] = bfhi(w.y);
                kf[8 * c + 4] = bflo(w.z); kf[8 * c + 5] = bfhi(w.z); kf[8 * c + 6] = bflo(w.w); kf[8 * c + 7] = bfhi(w.w); }
            float score = 0.f;
            for (int h = 0; h < 16; ++h) { float d = 0.f;
#pragma unroll
                for (int e = 0; e < 64; ++e) d += qf[h * 64 + e] * kf[e];
                score += wf[h] * fmaxf(d, 0.f); }
            sc[s] = score;
        }
        __syncthreads();
        const int n = i + 1;
        unsigned T = 0u;
        if (n > TOPK) {
            for (int bit = 31; bit >= 0; --bit) {
                const unsigned cand = T | (1u << bit);
                int cnt = 0;
                for (int s = tid; s <= i; s += NTHR) cnt += (okey(sc[s]) >= cand) ? 1 : 0;
                cnt = wave_sum_i(cnt);
                if (F.lane == 0) red[F.wave] = cnt;
                __syncthreads();
                int tot = 0;
#pragma unroll
                for (int w = 0; w < 8; ++w) tot += red[w];
                __syncthreads();
                if (tot >= TOPK) T = cand;
            }
        }
        if (tid < 64) { unsigned w = 0u;
            for (int j = 0; j < 32; ++j) { const int s = 32 * tid + j; if (s <= i && (n <= TOPK || okey(sc[s]) >= T)) w |= (1u << j); }
            F.Mask[(size_t)t * 64 + tid] = w; }
        __syncthreads();
    }
}

DI void p_dsa_naive(Frame& F) {
    LAS int* sel = (LAS int*)F.lds;
    LAS int* cw = sel + 320;
    LAS float* lg = (LAS float*)(cw + 80);
    const int tid = F.tid, lane = F.lane, h = F.wave;
    bf16* Y = F.Yb + (size_t)MTOK * 1024;
    for (int t = blockIdx.x; t < MTOK; t += F.G) {
        const int b = t / SEQ, i = t % SEQ;
        unsigned mw = 0u;
        if (tid < 64) { mw = F.Mask[(size_t)t * 64 + tid]; cw[tid] = __popc(mw); }
        __syncthreads();
        if (tid == 0) { int run = 0; for (int k = 0; k < 64; ++k) { const int c = cw[k]; cw[k] = run; run += c; } cw[64] = run; }
        __syncthreads();
        if (tid < 64) { int o = cw[tid]; unsigned w = mw; while (w) { const int j = __ffs(w) - 1; w &= w - 1u; if (o < 320) sel[o] = 32 * tid + j; ++o; } }
        __syncthreads();
        const int nsel = cw[64] < 320 ? cw[64] : 320;
        const bf16* zrow = F.Z + (size_t)t * ZLD;
        const unsigned qw = *(const unsigned*)(zrow + ZC_AQ + h * 128 + 2 * lane);
        const float q0 = bflo(qw), q1 = bfhi(qw);
        const float slope = exp2f(-(float)(h + 1));
        float mx = -1e30f;
        for (int idx = 0; idx < nsel; ++idx) {
            const int j = sel[idx];
            const unsigned kw = *(const unsigned*)(F.Z + (size_t)(b * SEQ + j) * ZLD + ZC_AK + h * 128 + 2 * lane);
            const float d = wave_sum(q0 * bflo(kw) + q1 * bfhi(kw));
            const float l = d - slope * (float)(i - j);
            if (lane == 0) lg[h * 320 + idx] = l;
            mx = fmaxf(mx, l);
        }
        float sum = 0.f;
        for (int idx = lane; idx < nsel; idx += 64) sum += __expf(lg[h * 320 + idx] - mx);
        sum = wave_sum(sum);
        const float inv = 1.f / sum;
        float a0 = 0.f, a1 = 0.f;
        for (int idx = 0; idx < nsel; ++idx) {
            const int j = sel[idx];
            const float p = __expf(lg[h * 320 + idx] - mx) * inv;
            const unsigned vw = *(const unsigned*)(F.Z + (size_t)(b * SEQ + j) * ZLD + ZC_AV + h * 128 + 2 * lane);
            a0 += p * bflo(vw); a1 += p * bfhi(vw);
        }
        const unsigned gw = *(const unsigned*)(zrow + ZC_AG + h * 128 + 2 * lane);
        *(unsigned*)(Y + (size_t)t * 1024 + h * 128 + 2 * lane) = pk2(silu_f(bflo(gw)) * a0, silu_f(bfhi(gw)) * a1);
        __syncthreads();
    }
}

DI void p_ret_naive(Frame& F) {
    const int lane = F.lane, h = F.wave;
    const float log_g = log1pf(-exp2f(-5.f - (float)h));
    for (int t = blockIdx.x; t < MTOK; t += F.G) {
        const int b = t / SEQ, i = t % SEQ;
        const bf16* zrow = F.Z + (size_t)t * ZLD;
        const unsigned qw = *(const unsigned*)(zrow + ZC_RQ + h * 128 + 2 * lane);
        const float q0 = bflo(qw), q1 = bfhi(qw);
        float a0 = 0.f, a1 = 0.f;
        for (int j = 0; j <= i; ++j) {
            const bf16* kr = F.Z + (size_t)(b * SEQ + j) * ZLD;
            const unsigned kw = *(const unsigned*)(kr + ZC_RK + h * 128 + 2 * lane);
            const unsigned vw = *(const unsigned*)(kr + ZC_RV + h * 128 + 2 * lane);
            const float d = wave_sum(q0 * bflo(kw) + q1 * bfhi(kw)) * __expf(log_g * (float)(i - j));
            a0 += d * bflo(vw); a1 += d * bfhi(vw);
        }
        const float mean = wave_sum(a0 + a1) * (1.f / 128.f);
        const float d0 = a0 - mean, d1 = a1 - mean;
        const float var = wave_sum(d0 * d0 + d1 * d1) * (1.f / 128.f);
        const float rs = 1.0f / sqrtf(var + 1e-5f);
        const float w0 = F.gn_w[h * 128 + 2 * lane], w1 = F.gn_w[h * 128 + 2 * lane + 1];
        const unsigned gw = *(const unsigned*)(zrow + ZC_RG + h * 128 + 2 * lane);
        *(unsigned*)(F.Yb + (size_t)t * 1024 + h * 128 + 2 * lane) = pk2(silu_f(bflo(gw)) * d0 * rs * w0, silu_f(bfhi(gw)) * d1 * rs * w1);
    }
}

DI void p_mem_naive(Frame& F) {
    LAS float* lg = (LAS float*)F.lds;
    const int lane = F.lane, w = F.wave, hh = w & 3;
    bf16* Y = F.Yb + (size_t)2 * MTOK * 1024;
    for (int t2 = blockIdx.x; t2 < MTOK / 2; t2 += F.G) {
        const int t = 2 * t2 + (w >> 2), b = t / SEQ;
        const bf16* zrow = F.Z + (size_t)t * ZLD;
        const u32x2 qw = *(const u32x2*)(zrow + ZC_MQ + hh * 256 + 4 * lane);
        const float q0 = bflo(qw.x), q1 = bfhi(qw.x), q2 = bflo(qw.y), q3 = bfhi(qw.y);
        float mx = -1e30f;
        for (int m = 0; m < MEMT; ++m) {
            const u32x2 kw = *(const u32x2*)(F.KVm + (size_t)(b * MEMT + m) * 2048 + hh * 256 + 4 * lane);
            const float d = wave_sum(q0 * bflo(kw.x) + q1 * bfhi(kw.x) + q2 * bflo(kw.y) + q3 * bfhi(kw.y));
            if (lane == 0) lg[w * 256 + m] = d;
            mx = fmaxf(mx, d);
        }
        float sum = 0.f;
        for (int m = lane; m < MEMT; m += 64) sum += __expf(lg[w * 256 + m] - mx);
        sum = wave_sum(sum);
        const float inv = 1.f / sum;
        float a0 = 0.f, a1 = 0.f, a2 = 0.f, a3 = 0.f;
        for (int m = 0; m < MEMT; ++m) {
            const float p = __expf(lg[w * 256 + m] - mx) * inv;
            const u32x2 vw = *(const u32x2*)(F.KVm + (size_t)(b * MEMT + m) * 2048 + 1024 + hh * 256 + 4 * lane);
            a0 += p * bflo(vw.x); a1 += p * bfhi(vw.x); a2 += p * bflo(vw.y); a3 += p * bfhi(vw.y);
        }
        const u32x2 gw = *(const u32x2*)(zrow + ZC_MG + hh * 256 + 4 * lane);
        u32x2 o; o.x = pk2(silu_f(bflo(gw.x)) * a0, silu_f(bfhi(gw.x)) * a1); o.y = pk2(silu_f(bflo(gw.y)) * a2, silu_f(bfhi(gw.y)) * a3);
        *(u32x2*)(Y + (size_t)t * 1024 + hh * 256 + 4 * lane) = o;
    }
}

DI void p_final(Frame& F) {
    const int gw = blockIdx.x * NWAVES + F.wave, NGW = F.G * NWAVES, lane = F.lane;
    for (int m = gw; m < MTOK; m += NGW) {
        f32x4* orow = (f32x4*)(F.out + (size_t)m * DM) + lane; const f32x4* xr = (const f32x4*)(F.x + (size_t)m * DM) + lane; const f32x4* wr = (const f32x4*)F.post_w + lane;
        f32x4 v[8]; float s = 0.f;
#pragma unroll
        for (int j = 0; j < 8; ++j) { v[j] = orow[64 * j]; s += (v[j].x * v[j].x + v[j].y * v[j].y) + (v[j].z * v[j].z + v[j].w * v[j].w); }
        const float r = 1.0f / sqrtf(wave_sum(s) * (1.f / DM) + 1e-6f);
#pragma unroll
        for (int j = 0; j < 8; ++j) orow[64 * j] = xr[64 * j] + v[j] * r * wr[64 * j];
    }
}


namespace att {
typedef float f32x16 __attribute__((ext_vector_type(16)));
typedef short v4i16_t __attribute__((ext_vector_type(4)));
typedef __bf16 bf16x2_t __attribute__((ext_vector_type(2)));
typedef float f32x2_t __attribute__((ext_vector_type(2)));
constexpr float LOG2E = 1.4426950408889634f;
DI unsigned off_b(unsigned row, unsigned ch) { return 256u * row + 16u * (ch ^ (((row & 3) << 2) | ((row >> 2) & 3))); }
DI f32x16 mfma32(bf16x8 a, bf16x8 b, f32x16 c) { return __builtin_amdgcn_mfma_f32_32x32x16_bf16(a, b, c, 0, 0, 0); }
DI unsigned cvtpk(float lo, float hi) { f32x2_t v = {lo, hi}; bf16x2_t o = __builtin_convertvector(v, bf16x2_t); return __builtin_bit_cast(unsigned, o); }
DI float max3f(float a, float b, float c) { float r; asm("v_max3_f32 %0, %1, %2, %3" : "=v"(r) : "v"(a), "v"(b), "v"(c)); return r; }
DI v4i16_t vtr(unsigned addr) { return __builtin_amdgcn_ds_read_tr16_b64_v4i16((LAS v4i16_t*)(uintptr_t)addr); }
DI bf16x8 pack8(const f32x16& x, int s) { u32x4 p; p.x = cvtpk(x[8 * s + 0], x[8 * s + 1]); p.y = cvtpk(x[8 * s + 2], x[8 * s + 3]); p.z = cvtpk(x[8 * s + 4], x[8 * s + 5]); p.w = cvtpk(x[8 * s + 6], x[8 * s + 7]); return __builtin_bit_cast(bf16x8, p); }

constexpr int ATT_SLOT = 34816, ATT_NSLOT = 4;
DI void glds16(const void* gsrc, unsigned lds_dst) { unsigned keep;
    asm volatile("s_mov_b32 %0, m0\n\ts_mov_b32 m0, %2\n\ts_nop 0\n\tglobal_load_lds_dwordx4 %1, off\n\ts_mov_b32 m0, %0" : "=&s"(keep) : "v"(gsrc), "s"(lds_dst) : "memory"); }
DI void glds4(const void* gsrc, unsigned lds_dst) { unsigned keep;
    asm volatile("s_mov_b32 %0, m0\n\ts_mov_b32 m0, %2\n\ts_nop 0\n\tglobal_load_lds_dword %1, off\n\ts_mov_b32 m0, %0" : "=&s"(keep) : "v"(gsrc), "s"(lds_dst) : "memory"); }
template <int MODE> DI void attn_unit(Frame& F, int b, int h, int qb) {
    const int lane = F.lane, w = F.wave, r = lane & 31, hh = lane >> 5;
    const int q0 = qb * 256, qrow = q0 + 32 * w + r, qt = 8 * qb + w;
    constexpr int zq = MODE ? ZC_AQ : ZC_RQ, zk = MODE ? ZC_AK : ZC_RK, zv = MODE ? ZC_AV : ZC_RV, zg = MODE ? ZC_AG : ZC_RG;
    const bf16* Zb = F.Z + (size_t)b * SEQ * ZLD;
    const unsigned ldsb = (unsigned)(uintptr_t)F.lds;
    bf16x8 qf[8];
    { const bf16* qp = Zb + (size_t)qrow * ZLD + zq + h * 128 + 8 * hh;
#pragma unroll
      for (int ks = 0; ks < 8; ++ks) qf[ks] = *(const bf16x8*)(qp + 16 * ks); }
    size_t goff[2];
#pragma unroll
    for (int j = 0; j < 2; ++j) { const int row = 4 * (2 * w + j) + (lane >> 4), ch = (lane & 15) ^ (((row & 3) << 2) | ((row >> 2) & 3)); goff[j] = (size_t)row * ZLD + h * 128 + ch * 8; }
    const unsigned* mg = F.Mask + (size_t)(b * SEQ + q0 + 32 * w + (lane >> 1)) * 64 + (lane & 1);
#define ATT_STAGE(sidx, slot) do { const bf16* kz_ = Zb + (size_t)(64 * (sidx)) * ZLD; const unsigned sb_ = __builtin_amdgcn_readfirstlane(ldsb + (slot) * ATT_SLOT + w * 2048); \
        glds16(kz_ + zk + goff[0], sb_); glds16(kz_ + zk + goff[1], sb_ + 1024); glds16(kz_ + zv + goff[0], sb_ + 16384); glds16(kz_ + zv + goff[1], sb_ + 16384 + 1024); \
        if (MODE) glds4(mg + 2 * (sidx), __builtin_amdgcn_readfirstlane(ldsb + (slot) * ATT_SLOT + 32768 + w * 256)); } while (0)
    unsigned kaddr[8], vaddr[4][2];
#pragma unroll
    for (int ks = 0; ks < 8; ++ks) kaddr[ks] = off_b(r, 2 * ks + hh);
    { const unsigned blk = (lane >> 4) & 1, q = (lane & 15) >> 2, p = lane & 3;
#pragma unroll
      for (int c = 0; c < 4; ++c)
#pragma unroll
        for (int t = 0; t < 2; ++t) vaddr[c][t] = off_b(8 * t + 4 * hh + q, 4 * c + 2 * blk + (p >> 1)) + 8 * (p & 1); }
    const float slope2 = exp2f(-(float)(h + 1)) * LOG2E;
    f32x16 o[4];
#pragma unroll
    for (int c = 0; c < 4; ++c)
#pragma unroll
        for (int i = 0; i < 16; ++i) o[c][i] = 0.f;
    float m = -1e30f, l = 0.f;
    const int nst = 4 * (qb + 1);
    ATT_STAGE(nst - 1, 0); ATT_STAGE(nst - 2, 1); ATT_STAGE(nst - 3, 2);
    if (MODE) asm volatile("s_waitcnt vmcnt(10)" ::: "memory"); else asm volatile("s_waitcnt vmcnt(8)" ::: "memory");
    __builtin_amdgcn_s_barrier(); asm volatile("" ::: "memory");
#pragma unroll 1
    for (int it = 0; it < nst; ++it) {
        const int st = nst - 1 - it, cur = it & 3;
        { const int sn = st - 3 < 0 ? 0 : st - 3; ATT_STAGE(sn, (it + 3) & 3); }
        const unsigned kb = ldsb + cur * ATT_SLOT, vb = kb + 16384;
        const int kt0 = 2 * st;
        if (kt0 <= qt) {
            bf16x8 kf0[8], kf1[8];
#pragma unroll
            for (int ks = 0; ks < 8; ++ks) kf0[ks] = *(const LAS bf16x8*)(uintptr_t)(kb + kaddr[ks]);
#pragma unroll
            for (int ks = 0; ks < 8; ++ks) kf1[ks] = *(const LAS bf16x8*)(uintptr_t)(kb + 8192 + kaddr[ks]);
            u32x2 mw = {0u, 0u};
            if (MODE) mw = *(const LAS u32x2*)(F.lds + cur * ATT_SLOT + 32768 + (32 * w + r) * 8);
            f32x16 s0, s1;
#pragma unroll
            for (int i = 0; i < 16; ++i) { s0[i] = 0.f; s1[i] = 0.f; }
#pragma unroll
            for (int ks = 0; ks < 8; ++ks) s0 = mfma32(kf0[ks], qf[ks], s0);
#pragma unroll
            for (int ks = 0; ks < 8; ++ks) s1 = mfma32(kf1[ks], qf[ks], s1);
            __builtin_amdgcn_sched_group_barrier(0x100, MODE ? 9 : 8, 0);
#pragma unroll
            for (int ks = 0; ks < 8; ++ks) { __builtin_amdgcn_sched_group_barrier(0x008, 1, 0); __builtin_amdgcn_sched_group_barrier(0x100, 1, 0); }
            __builtin_amdgcn_sched_group_barrier(0x008, 8, 0);
            if (MODE) {
                const unsigned mv0 = mw.x >> (4 * hh), mv1 = mw.y >> (4 * hh);
                const float tb = slope2 * (float)(32 * kt0 + 4 * hh - qrow);
                const float NEG = -1e30f;
                float mt = NEG;
#pragma unroll
                for (int i = 0; i < 16; ++i) { const int ci = (i & 3) + 8 * (i >> 2);
                    float u0 = s0[i] + slope2 * (float)ci, u1 = s1[i] + slope2 * (float)(ci + 32);
                    const int t0 = __builtin_amdgcn_sbfe((int)mv0, ci, 1), t1 = __builtin_amdgcn_sbfe((int)mv1, ci, 1);
                    u0 = __builtin_bit_cast(float, (__builtin_bit_cast(int, u0) & t0) | (__builtin_bit_cast(int, NEG) & ~t0));
                    u1 = __builtin_bit_cast(float, (__builtin_bit_cast(int, u1) & t1) | (__builtin_bit_cast(int, NEG) & ~t1));
                    s0[i] = u0; s1[i] = u1; mt = max3f(mt, u0, u1); }
                mt += tb;
                mt = fmaxf(mt, __shfl_xor(mt, 32));
                const float mn = fmaxf(m, mt), alpha = __builtin_amdgcn_exp2f(m - mn), cc = tb - mn; m = mn;
                float ps = 0.f;
#pragma unroll
                for (int i = 0; i < 16; ++i) { const float p0 = __builtin_amdgcn_exp2f(s0[i] + cc), p1 = __builtin_amdgcn_exp2f(s1[i] + cc); s0[i] = p0; s1[i] = p1; ps += p0 + p1; }
                l = l * alpha + ps;
                if (__any(alpha != 1.f)) {
#pragma unroll
                    for (int c = 0; c < 4; ++c)
#pragma unroll
                        for (int i = 0; i < 16; ++i) o[c][i] *= alpha; }
            } else {
                if (kt0 + 1 >= qt) {
                    const int dq = r + 32 * (qt - kt0) - 4 * hh;
#pragma unroll
                    for (int i = 0; i < 16; ++i) { const int ci = (i & 3) + 8 * (i >> 2); s0[i] = (ci <= dq) ? s0[i] : 0.f; s1[i] = (ci + 32 <= dq) ? s1[i] : 0.f; } }
            }
            const bf16x8 p00 = pack8(s0, 0), p01 = pack8(s0, 1), p10 = pack8(s1, 0), p11 = pack8(s1, 1);
#pragma unroll
            for (int c = 0; c < 4; ++c) {
                const v4i16_t a0 = vtr(vb + vaddr[c][0]), a1 = vtr(vb + vaddr[c][1]), a2 = vtr(vb + 4096 + vaddr[c][0]), a3 = vtr(vb + 4096 + vaddr[c][1]);
                const v4i16_t a4 = vtr(vb + 8192 + vaddr[c][0]), a5 = vtr(vb + 8192 + vaddr[c][1]), a6 = vtr(vb + 12288 + vaddr[c][0]), a7 = vtr(vb + 12288 + vaddr[c][1]);
                const bf16x8 A0 = {a0[0], a0[1], a0[2], a0[3], a1[0], a1[1], a1[2], a1[3]}, A1 = {a2[0], a2[1], a2[2], a2[3], a3[0], a3[1], a3[2], a3[3]};
                const bf16x8 A2 = {a4[0], a4[1], a4[2], a4[3], a5[0], a5[1], a5[2], a5[3]}, A3 = {a6[0], a6[1], a6[2], a6[3], a7[0], a7[1], a7[2], a7[3]};
                o[c] = mfma32(A0, p00, o[c]); o[c] = mfma32(A1, p01, o[c]); o[c] = mfma32(A2, p10, o[c]); o[c] = mfma32(A3, p11, o[c]);
            }
            __builtin_amdgcn_sched_group_barrier(0x100, 8, 1);
#pragma unroll
            for (int g = 0; g < 12; ++g) { __builtin_amdgcn_sched_group_barrier(0x008, 1, 1); __builtin_amdgcn_sched_group_barrier(0x100, 2, 1); }
            __builtin_amdgcn_sched_group_barrier(0x008, 4, 1);
        }
        if (MODE) asm volatile("s_waitcnt vmcnt(10) lgkmcnt(0)" ::: "memory"); else asm volatile("s_waitcnt vmcnt(8) lgkmcnt(0)" ::: "memory");
        __builtin_amdgcn_s_barrier(); asm volatile("" ::: "memory");
    }
    asm volatile("s_waitcnt vmcnt(0)" ::: "memory");
    __builtin_amdgcn_s_barrier(); asm volatile("" ::: "memory");
#undef ATT_STAGE
    const bf16* grow = Zb + (size_t)qrow * ZLD + zg + h * 128 + 4 * hh;
    bf16* yrow = F.Yb + (size_t)(MODE ? MTOK : 0) * 1024 + (size_t)(b * SEQ + qrow) * 1024 + h * 128 + 4 * hh;
    if (MODE) {
        const float lt = l + __shfl_xor(l, 32), inv = 1.f / lt;
#pragma unroll
        for (int c = 0; c < 4; ++c)
#pragma unroll
            for (int g = 0; g < 4; ++g) { const int d0 = 32 * c + 8 * g; const u32x2 gw = *(const u32x2*)(grow + d0);
                u32x2 ov; ov.x = pk2(silu_f(bflo(gw.x)) * o[c][4 * g + 0] * inv, silu_f(bfhi(gw.x)) * o[c][4 * g + 1] * inv);
                ov.y = pk2(silu_f(bflo(gw.y)) * o[c][4 * g + 2] * inv, silu_f(bfhi(gw.y)) * o[c][4 * g + 3] * inv);
                *(u32x2*)(yrow + d0) = ov; }
    } else {
        float sm = 0.f;
#pragma unroll
        for (int c = 0; c < 4; ++c)
#pragma unroll
            for (int i = 0; i < 16; ++i) sm += o[c][i];
        sm += __shfl_xor(sm, 32);
        const float mean = sm * (1.f / 128.f);
        float sv = 0.f;
#pragma unroll
        for (int c = 0; c < 4; ++c)
#pragma unroll
            for (int i = 0; i < 16; ++i) { const float d = o[c][i] - mean; sv += d * d; }
        sv += __shfl_xor(sv, 32);
        const float rs = 1.0f / sqrtf(sv * (1.f / 128.f) + 1e-5f);
        const float* gnw = F.gn_w + h * 128 + 4 * hh;
#pragma unroll
        for (int c = 0; c < 4; ++c)
#pragma unroll
            for (int g = 0; g < 4; ++g) { const int d0 = 32 * c + 8 * g; const u32x2 gw = *(const u32x2*)(grow + d0); const f32x4 wv = *(const f32x4*)(gnw + d0);
                u32x2 ov; ov.x = pk2(silu_f(bflo(gw.x)) * (o[c][4 * g + 0] - mean) * rs * wv.x, silu_f(bfhi(gw.x)) * (o[c][4 * g + 1] - mean) * rs * wv.y);
                ov.y = pk2(silu_f(bflo(gw.y)) * (o[c][4 * g + 2] - mean) * rs * wv.z, silu_f(bfhi(gw.y)) * (o[c][4 * g + 3] - mean) * rs * wv.w);
                *(u32x2*)(yrow + d0) = ov; }
    }
}
DI void p_attn(Frame& F) {
    for (int it = blockIdx.x; it < 256; it += F.G) {
        const int xcd = it & 7, j = it >> 3, bh = xcd * 4 + (j >> 3), qb = j & 7, b = bh >> 3, h = bh & 7;
#if PROBE_REPEAT == 31
        attn_unit<1>(F, b, h, qb);
#endif
#if PROBE_REPEAT == 30
        attn_unit<0>(F, b, h, 7 - qb);
#endif
        attn_unit<1>(F, b, h, qb);
        attn_unit<0>(F, b, h, 7 - qb);
    }
}
}


namespace idx {
using att::f32x16; using att::mfma32;
constexpr int QIMG = 0, QCOFF = 65536, WOFF = 65536 + 4096;
DI unsigned off_q(unsigned row, unsigned ch) { return 2048u * row + 16u * (ch ^ (((row & 3) << 2) | ((row >> 2) & 3))); }
DI unsigned off_c(unsigned row, unsigned c) { return 128u * row + 16u * (c ^ ((row >> 1) & 7)); }
DI float cand_f(unsigned c) { return __builtin_bit_cast(float, (c & 0x80000000u) ? (c & 0x7fffffffu) : ~c); }

DI void score_item(Frame& F, int b, int qi, int t0, int t1) {
    const int tid = F.tid, lane = F.lane, w = F.wave, r = lane & 31, hh = lane >> 5;
    const bf16* Zb = F.Z + (size_t)b * SEQ * ZLD;
    const int q0 = 32 * qi;
    const unsigned ldsb = (unsigned)(uintptr_t)F.lds;
    float* Sc = F.Sc + (size_t)(b * SEQ + q0) * SEQ;
#pragma unroll
    for (int i = 0; i < 8; ++i) { const int n = tid + 512 * i, row = n >> 7, ch = n & 127;
        const u32x4 v = *(const u32x4*)(Zb + (size_t)(q0 + row) * ZLD + ZC_IQ + ch * 8); *(LAS u32x4*)(F.lds + QIMG + off_q(row, ch)) = v; }
    { const int row = tid >> 4, hd = tid & 15; ((LAS float*)(F.lds + WOFF))[row * 17 + hd] = bf2f(Zb[(size_t)(q0 + row) * ZLD + ZC_IW + hd]); }
    __syncthreads();
    {
        const int row = tid >> 4, d4 = (tid & 15) * 4;
        const LAS float* wr = (const LAS float*)(F.lds + WOFF) + row * 17;
        float a0 = 0.f, a1 = 0.f, a2 = 0.f, a3 = 0.f;
#pragma unroll
        for (int hd = 0; hd < 16; ++hd) { const int e = 64 * hd + d4; const u32x2 qv = *(const LAS u32x2*)(F.lds + QIMG + off_q(row, e >> 3) + 2 * (e & 7)); const float wv = wr[hd];
            a0 += wv * bflo(qv.x); a1 += wv * bfhi(qv.x); a2 += wv * bflo(qv.y); a3 += wv * bfhi(qv.y); }
        u32x2 o; o.x = pk2(a0, a1); o.y = pk2(a2, a3);
        *(LAS u32x2*)(F.lds + QCOFF + off_c(row, d4 >> 3) + 2 * (d4 & 7)) = o;
    }
    __syncthreads();
    const unsigned fx = (((r & 3) << 2) | ((r >> 2) & 3)) ^ hh;
    const unsigned qbase = ldsb + QIMG + 2048u * r;
    const LAS float* wl = (const LAS float*)(F.lds + WOFF) + r * 17;
    bf16x8 qcf[4];
#pragma unroll
    for (int ks = 0; ks < 4; ++ks) qcf[ks] = *(const LAS bf16x8*)(F.lds + QCOFF + off_c(r, 2 * ks + hh));
#pragma unroll 1
    for (int kt = t0 + w; kt < t1; kt += 16) {
        const int ktb = (kt + 8 < 64) ? kt + 8 : 63;
        const bf16* ka_p = Zb + (size_t)(32 * kt + r) * ZLD + ZC_IK + 8 * hh;
        const bf16* kb_p = Zb + (size_t)(32 * ktb + r) * ZLD + ZC_IK + 8 * hh;
        bf16x8 ka[4], kb[4];
#pragma unroll
        for (int ks = 0; ks < 4; ++ks) { ka[ks] = *(const bf16x8*)(ka_p + 16 * ks); kb[ks] = *(const bf16x8*)(kb_p + 16 * ks); }
        f32x16 sca, scb;
#pragma unroll
        for (int i = 0; i < 16; ++i) { sca[i] = 0.f; scb[i] = 0.f; }
#pragma unroll 1
        for (int h = 0; h < 16; ++h) {
            const unsigned xh = fx ^ ((h & 1) << 3), hb = qbase + 256u * (h >> 1);
            f32x16 sa, sb;
#pragma unroll
            for (int i = 0; i < 16; ++i) { sa[i] = 0.f; sb[i] = 0.f; }
#pragma unroll
            for (int ks = 0; ks < 4; ++ks) { const bf16x8 qf = *(const LAS bf16x8*)(uintptr_t)(hb + 16u * (xh ^ (2 * ks)));
                sa = mfma32(ka[ks], qf, sa); sb = mfma32(kb[ks], qf, sb); }
            const float wv = wl[h];
#pragma unroll
            for (int i = 0; i < 16; ++i) { sca[i] = __builtin_fmaf(__builtin_fabsf(sa[i]), wv, sca[i]); scb[i] = __builtin_fmaf(__builtin_fabsf(sb[i]), wv, scb[i]); }
        }
#pragma unroll
        for (int ks = 0; ks < 4; ++ks) { sca = mfma32(ka[ks], qcf[ks], sca); scb = mfma32(kb[ks], qcf[ks], scb); }
        float* srow = Sc + (size_t)r * SEQ + 32 * kt + 4 * hh;
#pragma unroll
        for (int g = 0; g < 4; ++g) *(f32x4*)(srow + 8 * g) = (f32x4){sca[4 * g], sca[4 * g + 1], sca[4 * g + 2], sca[4 * g + 3]};
        if (kt + 8 < t1) {
#pragma unroll
            for (int g = 0; g < 4; ++g) *(f32x4*)(srow + 256 + 8 * g) = (f32x4){scb[4 * g], scb[4 * g + 1], scb[4 * g + 2], scb[4 * g + 3]}; }
    }
    __syncthreads();
}
DI void p_scores(Frame& F) {
    for (int it = blockIdx.x; it < 256; it += F.G) {
        const int b = it & 3, pr = (it >> 2) & 31, half = it >> 7;
#pragma unroll 1
        for (int k = 0; k < 2; ++k) { const int qi = k ? 63 - pr : pr, n = qi + 1, mid = (n + 1) >> 1;
            score_item(F, b, qi, half ? mid : 0, half ? n : mid); }
    }
}
template <int NJ> DI int below_count(const float (&v)[32], float cf) {
    unsigned m0 = 0u, m1 = 0u, m2 = 0u, m3 = 0u;
#pragma unroll
    for (int j = 0; j < NJ; j += 4) {
        m0 = __builtin_amdgcn_alignbit(m0, __builtin_bit_cast(unsigned, v[j] - cf), 31);
        m1 = __builtin_amdgcn_alignbit(m1, __builtin_bit_cast(unsigned, v[j + 1] - cf), 31);
        m2 = __builtin_amdgcn_alignbit(m2, __builtin_bit_cast(unsigned, v[j + 2] - cf), 31);
        m3 = __builtin_amdgcn_alignbit(m3, __builtin_bit_cast(unsigned, v[j + 3] - cf), 31);
    }
    return (__builtin_popcount(m0) + __builtin_popcount(m1)) + (__builtin_popcount(m2) + __builtin_popcount(m3));
}
template <int NJ> DI void topk_row(Frame& F, int row, int qpos) {
    const int lane = F.lane;
    const float* srow = F.Sc + (size_t)row * SEQ + lane;
    const int nj = (qpos >> 6) + 1;
    float v[32];
    const float ninf = -__builtin_inff();
#pragma unroll
    for (int j = 0; j < NJ; ++j) { v[j] = ninf; if (j < nj) v[j] = srow[64 * j]; }
#pragma unroll
    for (int j = 0; j < NJ; ++j) if (64 * j + lane > qpos) v[j] = ninf;
    float Tf = -3.4028234663852886e38f;
    if (qpos + 1 > TOPK) {
        unsigned T = 0u;
#pragma unroll 1
        for (int bit = 31; bit >= 0; --bit) {
            const unsigned cand = T | (1u << bit);
            const int nb = below_count<NJ>(v, cand_f(cand));
            int below = 0;
#pragma unroll
            for (int bb = 0; bb < 6; ++bb) below += __builtin_popcountll(__ballot((nb >> bb) & 1)) << bb;
            const int cnt = 64 * NJ - below;
            if (cnt >= TOPK) { T = cand; if (cnt == TOPK) break; }
        }
        Tf = cand_f(T);
    }
    unsigned word = 0u;
#pragma unroll
    for (int j = 0; j < NJ; ++j) { const unsigned long long bal = __ballot(v[j] >= Tf); if ((lane >> 1) == j) word = (lane & 1) ? (unsigned)(bal >> 32) : (unsigned)bal; }
    F.Mask[(size_t)row * 64 + lane] = word;
}
DI void p_topk(Frame& F) {
    const int gw = blockIdx.x * NWAVES + F.wave, NGW = F.G * NWAVES;
#pragma unroll 1
    for (int rr = gw; rr < MTOK; rr += NGW) {
        const int b = rr >> 11, q = rr & (SEQ - 1), qpos = (b & 1) ? (SEQ - 1 - q) : q, row = b * SEQ + qpos;
        if (qpos < 512) topk_row<8>(F, row, qpos); else if (qpos < 1024) topk_row<16>(F, row, qpos); else if (qpos < 1536) topk_row<24>(F, row, qpos); else topk_row<32>(F, row, qpos);
    }
}
}


namespace mema {
using att::f32x16; using att::mfma32; using att::v4i16_t; using att::vtr; using att::pack8; using att::LOG2E; using att::off_b;
#define MEM_SB() __builtin_amdgcn_sched_barrier(0)
DI unsigned off_m(unsigned row, unsigned ch) { return 512u * row + 16u * (ch ^ (((row & 3) << 2) | ((row >> 2) & 3))); }
DI void mem_unit(Frame& F, int b, int hm, int qb) {
    const int tid = F.tid, lane = F.lane, w = F.wave, r = lane & 31, hh = lane >> 5;
    const int qrow = qb * 256 + 32 * w + r;
    const bf16* zrow = F.Z + (size_t)(b * SEQ + qrow) * ZLD;
    const unsigned ldsb = (unsigned)(uintptr_t)F.lds;
    const bf16* qp = zrow + ZC_MQ + hm * 256 + 8 * hh;
    const bf16* kvb = F.KVm + (size_t)(b * MEMT) * 2048 + hm * 256;
    f32x16 s[8];
    {
        const int srow = tid >> 5, sch = tid & 31;
        const bf16* kg = kvb + (size_t)srow * 2048 + sch * 8;
        unsigned lo[4];
#pragma unroll
        for (int i = 0; i < 4; ++i) lo[i] = off_m(srow + 16 * i, sch);
        unsigned ka8[8];
#pragma unroll
        for (int ks = 0; ks < 8; ++ks) ka8[ks] = off_m(r, 2 * ks + hh);
        u32x4 st0, st1, st2, st3;
#define MEM_LOADK(g) do { const bf16* p_ = kg + (size_t)(64 * (g)) * 2048; \
            st0 = *(const u32x4*)p_; st1 = *(const u32x4*)(p_ + (size_t)16 * 2048); st2 = *(const u32x4*)(p_ + (size_t)32 * 2048); st3 = *(const u32x4*)(p_ + (size_t)48 * 2048); } while (0)
#define MEM_WRITEK(g) do { LAS unsigned char* d_ = F.lds + ((g) & 1) * 32768; \
            *(LAS u32x4*)(d_ + lo[0]) = st0; *(LAS u32x4*)(d_ + lo[1]) = st1; *(LAS u32x4*)(d_ + lo[2]) = st2; *(LAS u32x4*)(d_ + lo[3]) = st3; } while (0)
        MEM_LOADK(0); MEM_WRITEK(0);
        __syncthreads();
#pragma unroll
        for (int st = 0; st < 4; ++st) {
            if (st < 3) MEM_LOADK(st + 1);
            const unsigned kb = ldsb + (st & 1) * 32768;
            f32x16 a0, a1;
#pragma unroll
            for (int i = 0; i < 16; ++i) { a0[i] = 0.f; a1[i] = 0.f; }
#pragma unroll
            for (int kq = 0; kq < 4; ++kq) {
                bf16x8 qf[4];
#pragma unroll
                for (int k4 = 0; k4 < 4; ++k4) qf[k4] = *(const bf16x8*)(qp + 16 * (4 * kq + k4));
#pragma unroll
                for (int k4 = 0; k4 < 4; ++k4) { const int ks = 4 * kq + k4;
                    const bf16x8 k0 = *(const LAS bf16x8*)(uintptr_t)(kb + (ks >> 3) * 256 + ka8[ks & 7]), k1 = *(const LAS bf16x8*)(uintptr_t)(kb + 16384 + (ks >> 3) * 256 + ka8[ks & 7]);
                    a0 = mfma32(k0, qf[k4], a0); a1 = mfma32(k1, qf[k4], a1); }
                MEM_SB();
            }
            s[2 * st] = a0; s[2 * st + 1] = a1;
            if (st < 3) MEM_WRITEK(st + 1);
            __syncthreads();
            MEM_SB();
        }
#undef MEM_LOADK
#undef MEM_WRITEK
    }
    float mx = -1e30f;
#pragma unroll
    for (int t = 0; t < 8; ++t)
#pragma unroll
        for (int i = 0; i < 16; ++i) mx = fmaxf(mx, s[t][i]);
    mx = fmaxf(mx, __shfl_xor(mx, 32));
    const float mL = mx * LOG2E;
    float l = 0.f;
    bf16x8 pf[8][2];
#pragma unroll
    for (int t = 0; t < 8; ++t) {
#pragma unroll
        for (int i = 0; i < 16; ++i) { const float p = __builtin_amdgcn_exp2f(__builtin_fmaf(s[t][i], LOG2E, -mL)); s[t][i] = p; l += p; }
        pf[t][0] = pack8(s[t], 0); pf[t][1] = pack8(s[t], 1);
    }
    l += __shfl_xor(l, 32);
    const float inv = 1.f / l;
    MEM_SB();
    {
        const int srow = tid >> 4, sch = tid & 15;
        const bf16* vg = kvb + 1024 + (size_t)srow * 2048 + sch * 8;
        const unsigned lo0 = off_b(srow, sch), lo1 = off_b(srow + 32, sch);
        unsigned vaddr[4][2];
        { const unsigned blk = (lane >> 4) & 1, q = (lane & 15) >> 2, p = lane & 3;
#pragma unroll
          for (int c = 0; c < 4; ++c)
#pragma unroll
            for (int t = 0; t < 2; ++t) vaddr[c][t] = off_b(8 * t + 4 * hh + q, 4 * c + 2 * blk + (p >> 1)) + 8 * (p & 1); }
        u32x4 v0, v1;
#define MEM_LOADV(g) do { const bf16* p_ = vg + ((g) >> 2) * 128 + (size_t)(64 * ((g) & 3)) * 2048; v0 = *(const u32x4*)p_; v1 = *(const u32x4*)(p_ + (size_t)32 * 2048); } while (0)
#define MEM_WRITEV(g) do { LAS unsigned char* d_ = F.lds + ((g) & 1) * 32768; *(LAS u32x4*)(d_ + lo0) = v0; *(LAS u32x4*)(d_ + lo1) = v1; } while (0)
        MEM_LOADV(0); MEM_WRITEV(0);
        __syncthreads();
        const bf16* grow = zrow + ZC_MG + hm * 256 + 4 * hh;
        bf16* yrow = F.Yb + (size_t)2 * MTOK * 1024 + (size_t)(b * SEQ + qrow) * 1024 + hm * 256 + 4 * hh;
        f32x16 o[4];
#pragma unroll
        for (int g = 0; g < 8; ++g) {
            const int st = g & 3;
            if (st == 0) {
#pragma unroll
                for (int c = 0; c < 4; ++c)
#pragma unroll
                    for (int i = 0; i < 16; ++i) o[c][i] = 0.f; }
            if (g < 7) MEM_LOADV(g + 1);
            const unsigned vb = ldsb + (g & 1) * 32768;
#pragma unroll
            for (int tt = 0; tt < 2; ++tt) {
#pragma unroll
                for (int c = 0; c < 4; ++c) {
                    const unsigned va = vb + tt * 8192;
                    const v4i16_t a00 = vtr(va + vaddr[c][0]), a01 = vtr(va + vaddr[c][1]), a10 = vtr(va + 4096 + vaddr[c][0]), a11 = vtr(va + 4096 + vaddr[c][1]);
                    const bf16x8 A0 = {a00[0], a00[1], a00[2], a00[3], a01[0], a01[1], a01[2], a01[3]};
                    const bf16x8 A1 = {a10[0], a10[1], a10[2], a10[3], a11[0], a11[1], a11[2], a11[3]};
                    o[c] = mfma32(A0, pf[2 * st + tt][0], o[c]); o[c] = mfma32(A1, pf[2 * st + tt][1], o[c]);
                }
            }
            if (g < 7) MEM_WRITEV(g + 1);
            __syncthreads();
            MEM_SB();
            if (st == 3) {
                const int dh = (g >> 2) * 128;
#pragma unroll
                for (int c = 0; c < 4; ++c)
#pragma unroll
                    for (int gg = 0; gg < 4; ++gg) { const int d0 = dh + 32 * c + 8 * gg; const u32x2 gw = *(const u32x2*)(grow + d0);
                        u32x2 ov; ov.x = pk2(silu_f(bflo(gw.x)) * o[c][4 * gg + 0] * inv, silu_f(bfhi(gw.x)) * o[c][4 * gg + 1] * inv);
                        ov.y = pk2(silu_f(bflo(gw.y)) * o[c][4 * gg + 2] * inv, silu_f(bfhi(gw.y)) * o[c][4 * gg + 3] * inv);
                        *(u32x2*)(yrow + d0) = ov; }
                MEM_SB();
            }
        }
#undef MEM_LOADV
#undef MEM_WRITEV
    }
}
#undef MEM_SB
DI void p_mem(Frame& F) {
    for (int u = blockIdx.x; u < 128; u += F.G) { const int xcd = u & 7, j = u >> 3, bhm = xcd * 2 + (j >> 3), qb = j & 7; mem_unit(F, bhm >> 2, bhm & 3, qb); }
}
}

constexpr int N_PHASES = 8;
struct Args { const float* in[12]; float* out; unsigned char* ws; int ph_lo, ph_hi; };
__global__ void __launch_bounds__(NTHR, 2) layer_fwd(Args args) {
    extern __shared__ __attribute__((aligned(16))) unsigned char lds[];
    Frame F;
    F.lds = (LAS unsigned char*)lds;
    F.tid = threadIdx.x; F.lane = F.tid & 63; F.wave = __builtin_amdgcn_readfirstlane(F.tid >> 6); F.G = gridDim.x;
    unsigned char* ws = args.ws;
    F.x = args.in[0]; F.mem = args.in[1]; F.pre_w = args.in[2]; F.w_in = args.in[3]; F.gn_w = args.in[4]; F.memn_w = args.in[5]; F.w_kv = args.in[6];
    F.w_up[0] = args.in[7]; F.w_up[1] = args.in[8]; F.w_up[2] = args.in[9]; F.w_o = args.in[10]; F.post_w = args.in[11]; F.out = args.out;
    F.WinT = (bf16*)(ws + WS_WINT); F.WkvT = (bf16*)(ws + WS_WKVT); F.WupT = (bf16*)(ws + WS_WUPT); F.WoT = (bf16*)(ws + WS_WOT);
    F.Hb = (bf16*)(ws + WS_HB); F.MemN = (bf16*)(ws + WS_MEMN); F.KVm = (bf16*)(ws + WS_KVM); F.Yb = (bf16*)(ws + WS_YB); F.Z = (bf16*)(ws + WS_Z);
    F.Merged = (bf16*)(ws + WS_MERGED); F.Mrg = (float*)(ws + WS_MRG); F.Sc = (float*)(ws + WS_WINT); F.Mask = (unsigned*)(ws + WS_MASK);
    volatile LAS unsigned* MISC = (volatile LAS unsigned*)(F.lds + MISC_OFF);
    if (F.tid < 32) MISC[F.tid] = 0u;
    __syncthreads();
    const int lo = args.ph_lo, hi = args.ph_hi;
    const bool one = (hi - lo) > 1;
    XcdBarrier bar; bar.bar = (unsigned*)(ws + WS_CTL) + CW_BAR; bar.x = 0; bar.st = nullptr;
    if (one) bar = xcd_barrier_post((unsigned*)(ws + WS_CTL) + CW_BAR, MISC + 8);
#define IN(k) (lo <= (k) && (k) < hi)
#define SEAM(k) do { if (IN(k) && IN((k) + 1)) xcd_barrier(bar); } while (0)
    if (IN(0)) { p0_prologue(F); } SEAM(0);
    if (IN(1)) {
        if (PROBE_REPEAT == 1) { pg8::GemmG g{DM, DM, DM}; pg8::SchedP1 S{F.G, (int)blockIdx.x, (const char*)F.Hb, (const char*)F.WinT, (const char*)F.MemN, (const char*)F.WkvT};
            pg8::EpiZ E{F.Z, F.KVm}; pg8::gemm_phase<pg8::EpiZ, pg8::SchedP1, true, true>(F.lds, g, S, E); xcd_barrier(bar); }
        pg8::GemmG g{DM, DM, DM}; pg8::SchedP1 S{F.G, (int)blockIdx.x, (const char*)F.Hb, (const char*)F.WinT, (const char*)F.MemN, (const char*)F.WkvT};
        pg8::EpiZ E{F.Z, F.KVm};
        pg8::gemm_phase<pg8::EpiZ, pg8::SchedP1, true, true>(F.lds, g, S, E);
    } SEAM(1);
    if (IN(2)) {
        if (PROBE_REPEAT == 20) { idx::p_scores(F); xcd_barrier(bar); }
        if (PROBE_REPEAT == 21) { mema::p_mem(F); xcd_barrier(bar); }
        idx::p_scores(F); mema::p_mem(F);
    } SEAM(2);
    if (IN(3)) { if (PROBE_REPEAT == 3) { idx::p_topk(F); xcd_barrier(bar); } idx::p_topk(F); } SEAM(3);
    if (IN(4)) { att::p_attn(F); } SEAM(4);
    if (IN(5)) {
        pg8::GemmG g{1024, 1024, 1024}; pg8::SchedTile S{F.G, (int)blockIdx.x, 3, (const char*)F.Yb, (const char*)F.WupT, (size_t)MTOK * 1024 * 2, (size_t)DM * 1024 * 2, 1024, 1024};
        pg8::EpiGate E{F.Z, F.Merged};
        pg8::gemm_phase<pg8::EpiGate, pg8::SchedTile, true, true>(F.lds, g, S, E);
    } SEAM(5);
    if (IN(6)) {
        pg8::GemmG g{DM, DM, DM}; pg8::SchedTile S{F.G, (int)blockIdx.x, 1, (const char*)F.Merged, (const char*)F.WoT, 0, 0, DM, DM};
        pg8::EpiOutF32 E{F.out};
        pg8::gemm_phase<pg8::EpiOutF32, pg8::SchedTile, true, true>(F.lds, g, S, E);
    } SEAM(6);
    if (IN(7)) { p_final(F); }
#undef IN
#undef SEAM
}

extern "C" void kernel_launch(void* const* d_in, const int* in_sizes, int n_in, void* d_out, int out_size, void* d_ws, size_t ws_size, hipStream_t stream) {
    static int grid = 0;
    if (grid == 0) {
        if (n_in != 12 || out_size != MTOK * DM || ws_size < WS_END) { fprintf(stderr, "kernel_launch: unexpected problem (n_in %d, out %d, ws %zu)\n", n_in, out_size, ws_size); grid = -1; return; }
        int dev = 0, cus = 0;
        if (hipGetDevice(&dev) != hipSuccess || hipDeviceGetAttribute(&cus, hipDeviceAttributeMultiprocessorCount, dev) != hipSuccess) { grid = -1; return; }
        if (hipFuncSetAttribute((const void*)layer_fwd, hipFuncAttributeMaxDynamicSharedMemorySize, LDS_BYTES) != hipSuccess) { fprintf(stderr, "kernel_launch: hipFuncSetAttribute failed\n"); grid = -1; return; }
        int per_cu = 0;
        if (hipOccupancyMaxActiveBlocksPerMultiprocessor(&per_cu, (const void*)layer_fwd, NTHR, LDS_BYTES) != hipSuccess || per_cu < 1) fprintf(stderr, "kernel_launch: occupancy query reports %d\n", per_cu);
        (void)hipGetLastError();
        grid = cus;
    }
    if (grid < 0) return;
    (void)hipMemsetAsync((char*)d_ws + WS_CTL, 0, CTL_ZERO_BYTES, stream);
    Args a{};
    for (int i = 0; i < 12; ++i) a.in[i] = (const float*)d_in[i];
    a.out = (float*)d_out; a.ws = (unsigned char*)d_ws;
#if MK_N_LAUNCHES == 1
    a.ph_lo = 0; a.ph_hi = N_PHASES;
    hipLaunchKernelGGL(layer_fwd, dim3(grid), dim3(NTHR), LDS_BYTES, stream, a);
#else
    for (int p = 0; p < N_PHASES; ++p) { a.ph_lo = p; a.ph_hi = p + 1; hipLaunchKernelGGL(layer_fwd, dim3(grid), dim3(NTHR), LDS_BYTES, stream, a); }
#endif
}
```
